# Optimizing an MI355X kernel written in HIP

```python
import jax, jax.numpy as jnp
from jax import lax
import numpy as np

D_MODEL = 1024
BATCH = 8
SEQ = 4096
DEPTH = 1

CONV_WIDTH = D_MODEL
CONV_GROUPS = 8
CONV_KERNEL = 31
SGU_WIDTH = D_MODEL
SGU_HEADS = 8
SGU_HEAD_DIM = SGU_WIDTH // SGU_HEADS
CHUNK = 128
EPS = 1e-6

OFF_A_VAL = 0
OFF_A_GLU = OFF_A_VAL + CONV_WIDTH
OFF_A_SILU = OFF_A_GLU + CONV_WIDTH
OFF_B_U = OFF_A_SILU + CONV_WIDTH
OFF_B_V = OFF_B_U + SGU_WIDTH
OFF_B_SILU = OFF_B_V + SGU_WIDTH
OFF_G_A = OFF_B_SILU + SGU_WIDTH
OFF_G_B = OFF_G_A + D_MODEL
IN_COLS = OFF_G_B + D_MODEL

kernel_name = "hybrid_conformer_conv_gmlp_adaln"


def rmsnorm(x, g):
    x32 = x.astype(jnp.float32)
    y = x32 * lax.rsqrt(jnp.mean(x32 * x32, axis=-1, keepdims=True) + EPS)
    return y.astype(x.dtype) * g


def layernorm(x, g, b):
    x32 = x.astype(jnp.float32)
    mu = jnp.mean(x32, axis=-1, keepdims=True)
    xc = x32 - mu
    var = jnp.mean(xc * xc, axis=-1, keepdims=True)
    return (xc * lax.rsqrt(var + EPS)).astype(x.dtype) * g + b


def conformer_conv_branch(val, glu, z, conv_w, conv_b, ln_g, ln_b, w_out):
    a = val * jax.nn.sigmoid(glu)
    kern = conv_w.reshape(CONV_KERNEL, 1, CONV_WIDTH)
    y = lax.conv_general_dilated(
        a, kern, window_strides=(1,), padding=[(CONV_KERNEL - 1, 0)],
        dimension_numbers=("NWC", "WIO", "NWC"),
        feature_group_count=CONV_WIDTH) + conv_b
    y = jax.nn.silu(layernorm(y, ln_g, ln_b))
    y = y * jax.nn.silu(z)
    return y @ w_out


def sgu_branch(u, v, z, ln_g, ln_b, w_s, b_s, w_out):
    bsz, seq, _ = u.shape
    u = jax.nn.gelu(u, approximate=False)
    v = layernorm(jax.nn.gelu(v, approximate=False), ln_g, ln_b)
    vc = v.reshape(bsz, seq // CHUNK, CHUNK, SGU_HEADS, SGU_HEAD_DIM)
    causal = jnp.tril(jnp.ones((CHUNK, CHUNK), dtype=bool))
    ws = jnp.where(causal[None], w_s, jnp.zeros((), w_s.dtype))
    s = jnp.einsum("hts,bcshd->bcthd", ws, vc) + b_s.T[:, :, None]
    s = s.reshape(bsz, seq, SGU_WIDTH)
    y = u * s * jax.nn.silu(z)
    return y @ w_out


def setup_inputs(seed: int = 0) -> dict:
    key = jax.random.key(seed)
    ks = jax.random.split(key, 20)
    f32 = jnp.float32
    n = lambda k, shape, s: (jax.random.normal(k, shape, f32) * s)
    x = jax.random.normal(ks[0], (BATCH, SEQ, D_MODEL), f32)
    c = jax.random.normal(ks[1], (BATCH, D_MODEL), f32)
    w_ada = n(ks[2], (DEPTH, D_MODEL, 3 * D_MODEL), 0.3 * D_MODEL ** -0.5)
    b_ada = n(ks[3], (DEPTH, 3 * D_MODEL), 0.02)
    g_pre = 1.0 + n(ks[4], (DEPTH, D_MODEL), 0.02)
    w_in = n(ks[5], (DEPTH, D_MODEL, IN_COLS), D_MODEL ** -0.5)
    conv_w = n(ks[6], (DEPTH, CONV_KERNEL, CONV_WIDTH), CONV_KERNEL ** -0.5)
    conv_b = n(ks[7], (DEPTH, CONV_WIDTH), 0.02)
    conv_ln_g = 1.0 + n(ks[8], (DEPTH, CONV_WIDTH), 0.02)
    conv_ln_b = n(ks[9], (DEPTH, CONV_WIDTH), 0.02)
    w_conv_out = n(ks[10], (DEPTH, CONV_WIDTH, D_MODEL), CONV_WIDTH ** -0.5)
    sgu_ln_g = 1.0 + n(ks[11], (DEPTH, SGU_WIDTH), 0.02)
    sgu_ln_b = n(ks[12], (DEPTH, SGU_WIDTH), 0.02)
    w_sgu = n(ks[13], (DEPTH, SGU_HEADS, CHUNK, CHUNK), 0.5 * CHUNK ** -0.5)
    b_sgu = 1.0 + n(ks[14], (DEPTH, SGU_HEADS, CHUNK), 0.02)
    w_sgu_out = n(ks[15], (DEPTH, SGU_WIDTH, D_MODEL), SGU_WIDTH ** -0.5)
    w_o = n(ks[16], (DEPTH, D_MODEL, D_MODEL), D_MODEL ** -0.5)
    g_final = 1.0 + n(ks[17], (D_MODEL,), 0.02)
    return {"x": x, "c": c, "w_ada": w_ada, "b_ada": b_ada, "g_pre": g_pre, "w_in": w_in,
            "conv_w": conv_w, "conv_b": conv_b, "conv_ln_g": conv_ln_g, "conv_ln_b": conv_ln_b,
            "w_conv_out": w_conv_out, "sgu_ln_g": sgu_ln_g, "sgu_ln_b": sgu_ln_b,
            "w_sgu": w_sgu, "b_sgu": b_sgu, "w_sgu_out": w_sgu_out, "w_o": w_o,
            "g_final": g_final}


def reference(x, c, w_ada, b_ada, g_pre, w_in, conv_w, conv_b, conv_ln_g, conv_ln_b,
              w_conv_out, sgu_ln_g, sgu_ln_b, w_sgu, b_sgu, w_sgu_out, w_o, g_final):
    for l in range(DEPTH):
        mod = c @ w_ada[l] + b_ada[l]
        shift, scale, gate = jnp.split(mod, 3, axis=-1)
        h = rmsnorm(x, g_pre[l]) * (1.0 + scale[:, None, :]) + shift[:, None, :]
        p = h @ w_in[l]
        y_a = conformer_conv_branch(
            p[..., OFF_A_VAL:OFF_A_GLU], p[..., OFF_A_GLU:OFF_A_SILU], p[..., OFF_A_SILU:OFF_B_U],
            conv_w[l], conv_b[l], conv_ln_g[l], conv_ln_b[l], w_conv_out[l])
        y_b = sgu_branch(
            p[..., OFF_B_U:OFF_B_V], p[..., OFF_B_V:OFF_B_SILU], p[..., OFF_B_SILU:OFF_G_A],
            sgu_ln_g[l], sgu_ln_b[l], w_sgu[l], b_sgu[l], w_sgu_out[l])
        merged = (jax.nn.sigmoid(p[..., OFF_G_A:OFF_G_B]) * y_a
                  + jax.nn.sigmoid(p[..., OFF_G_B:IN_COLS]) * y_b)
        x = x + gate[:, None, :] * (merged @ w_o[l])
    return rmsnorm(x, g_final)
```

```cpp
#include <hip/hip_runtime.h>
#include <hip/hip_cooperative_groups.h>
#include <cstdio>
namespace cg = cooperative_groups;

#ifndef MK_SINGLE
#define MK_SINGLE 1
#endif
#ifndef GEMM_SIMPLE
#define GEMM_SIMPLE 0
#endif

#define LAS __attribute__((address_space(3)))
typedef unsigned short bf16_t;
typedef short bf16x8 __attribute__((ext_vector_type(8)));
typedef float f32x4 __attribute__((ext_vector_type(4)));
typedef float f32x2 __attribute__((ext_vector_type(2)));
typedef unsigned u32x4 __attribute__((ext_vector_type(4)));
typedef unsigned u32x2 __attribute__((ext_vector_type(2)));

constexpr int DM = 1024, NB = 8, SEQ = 4096, MT = NB * SEQ, NIN = 8192;
constexpr float EPS = 1e-6f;
constexpr int NTHREADS = 512;
constexpr int LDS_BYTES = 128 * 1024 + 4096;

constexpr size_t MB = 1024 * 1024;
constexpr size_t WS_WT1 = 0;
constexpr size_t WS_WT2 = 16 * MB;
constexpr size_t WS_WT3 = 18 * MB;
constexpr size_t WS_WT4 = 20 * MB;
constexpr size_t WS_WSB = 22 * MB;
constexpr size_t WS_MOD = 23 * MB;
constexpr size_t WS_VST = 24 * MB;
constexpr size_t WS_XST = 28 * MB;
constexpr size_t WS_H   = 32 * MB;
constexpr size_t WS_PA  = 96 * MB;
constexpr size_t WS_PZA = 160 * MB;
constexpr size_t WS_PUB = 224 * MB;
constexpr size_t WS_PVB = 288 * MB;
constexpr size_t WS_PGA = 352 * MB;
constexpr size_t WS_PGB = 416 * MB;
constexpr size_t WS_END = 480 * MB;

struct Args {
    const float *x, *c, *w_ada, *b_ada, *g_pre, *w_in, *conv_w, *conv_b, *conv_ln_g, *conv_ln_b, *w_conv_out,
        *sgu_ln_g, *sgu_ln_b, *w_sgu, *b_sgu, *w_sgu_out, *w_o, *g_final;
    float* out; unsigned char* ws; int ph_lo, ph_hi;
};

typedef __bf16 bf16x2_t __attribute__((ext_vector_type(2)));
__device__ __forceinline__ unsigned cvt_pk_bf16(float lo, float hi) { const f32x2 v = {lo, hi}; const bf16x2_t r = __builtin_convertvector(v, bf16x2_t); return __builtin_bit_cast(unsigned, r); }
__device__ __forceinline__ float bf_lo(unsigned u) { return __uint_as_float(u << 16); }
__device__ __forceinline__ float bf_hi(unsigned u) { return __uint_as_float(u & 0xffff0000u); }
__device__ __forceinline__ float wave_sum(float v) {
#pragma unroll
    for (int o = 32; o >= 1; o >>= 1) v += __shfl_xor(v, o);
    return v;
}
__device__ __forceinline__ float sigmoidf_(float x) { return __builtin_amdgcn_rcpf(1.0f + __builtin_amdgcn_exp2f(x * -1.44269504f)); }
__device__ __forceinline__ float siluf_(float x) { return x * sigmoidf_(x); }
__device__ __forceinline__ f32x2 gelu_pk(f32x2 v) {
    const f32x2 av = __builtin_elementwise_abs(v), d = av * 0.2316418882f + 1.0f;
    f32x2 t; t.x = __builtin_amdgcn_rcpf(d.x); t.y = __builtin_amdgcn_rcpf(d.y);
    f32x2 q = t * 0.5307027145f + (-0.7265760135f); q = q * t + 0.7107068705f; q = q * t + (-0.142248368f); q = q * t + 0.127414796f; q = q * t;
    const f32x2 s = (v * v) * (-0.72134752044f);
    f32x2 e; e.x = __builtin_amdgcn_exp2f(s.x); e.y = __builtin_amdgcn_exp2f(s.y);
    const f32x2 m = v * (q * e), r = v - m;
    f32x2 o; o.x = v.x < 0.f ? m.x : r.x; o.y = v.y < 0.f ? m.y : r.y; return o;
}
__device__ __forceinline__ f32x4 gelu4(f32x4 v) { f32x2 a = gelu_pk((f32x2){v[0], v[1]}), b = gelu_pk((f32x2){v[2], v[3]}); return (f32x4){a.x, a.y, b.x, b.y}; }
__device__ __forceinline__ f32x4 sig4(f32x4 v) { return (f32x4){sigmoidf_(v[0]), sigmoidf_(v[1]), sigmoidf_(v[2]), sigmoidf_(v[3])}; }
__device__ __forceinline__ f32x4 silu4(f32x4 v) { return v * sig4(v); }
__device__ __forceinline__ u32x4 pack8(f32x4 a, f32x4 b) { u32x4 w; w.x = cvt_pk_bf16(a[0], a[1]); w.y = cvt_pk_bf16(a[2], a[3]); w.z = cvt_pk_bf16(b[0], b[1]); w.w = cvt_pk_bf16(b[2], b[3]); return w; }

namespace pg8 {
constexpr int BM = 256, BK = 64, HALF = 128, HTB = HALF * BK * 2, STAGE_BYTES = 8 * HTB, NXCD = 8, WGM = 8;
__device__ __forceinline__ int lds_byte(int r, int c) { const int st = (r >> 4) * 2 + (c >> 5), rr = r & 15, cc = c & 31, ob = rr * 64 + cc * 2; return st * 1024 + (ob ^ (((ob >> 9) & 1) << 5)); }
__device__ __forceinline__ void stage_rc(int b, int& R, int& C) { const int st = b / 1024, sb = b % 1024, swz = sb ^ (((sb >> 9) & 1) << 5); R = (st >> 1) * 16 + swz / 64; C = (st & 1) * 32 + (swz % 64) / 2; }
__device__ __forceinline__ int perm32(int rho) { const int n = rho >> 4, i = rho & 15; return 8 * (i >> 2) + 4 * n + (i & 3); }

struct Unit { int pm, pn, part; };

__device__ __forceinline__ void tile_of(int wgid_in, int nM, int nN, int nwg, Unit& u) {
    int wgid = wgid_in; { const int q = nwg / NXCD, r = nwg % NXCD, xcd = wgid % NXCD, off = wgid / NXCD; wgid = (xcd < r ? xcd * (q + 1) : r * (q + 1) + (xcd - r) * q) + off; }
    const int nig = WGM * nN, gid = wgid / nig, fm = gid * WGM, gsz = (nM - fm) < WGM ? (nM - fm) : WGM;
    u.pm = fm + ((wgid % nig) % gsz); u.pn = (wgid % nig) / gsz;
}
struct OrderStd {
    int nM, nN, nwg, G, c; const char* A; const char* B; size_t tstep;
    __device__ void init(const void* A_, const void* B_, int M, int N, int K, int G_, int c_) { A = (const char*)A_; B = (const char*)B_; nM = M / BM; nN = N / BM; nwg = nM * nN; G = G_; c = c_; tstep = (size_t)BM * K * 2; }
    __device__ bool next(int i, Unit& u) const { const long L = (long)i * G + c; if (L >= nwg) return false; tile_of((int)L, nM, nN, nwg, u); u.part = 1; return true; }
    __device__ __forceinline__ const char* abase(const Unit& u) const { return A + (size_t)u.pm * tstep; }
    __device__ __forceinline__ const char* bbase(const Unit& u) const { return B + (size_t)u.pn * tstep; }
};
struct OrderDual {
    int nM, nN, nwg, G, c; const char *A0, *A1, *B0, *B1; size_t tstep;
    __device__ void init(const void* A0_, const void* A1_, const void* B0_, const void* B1_, int M, int N, int K, int G_, int c_) { A0 = (const char*)A0_; A1 = (const char*)A1_; B0 = (const char*)B0_; B1 = (const char*)B1_; nM = M / BM; nN = N / BM; nwg = nM * nN; G = G_; c = c_; tstep = (size_t)BM * K * 2; }
    __device__ bool next(int i, Unit& u) const { const long L = (long)(i >> 1) * G + c; if (L >= nwg) return false; tile_of((int)L, nM, nN, nwg, u); u.part = i & 1; return true; }
    __device__ __forceinline__ const char* abase(const Unit& u) const { return (u.part ? A1 : A0) + (size_t)u.pm * tstep; }
    __device__ __forceinline__ const char* bbase(const Unit& u) const { return (u.part ? B1 : B0) + (size_t)u.pn * tstep; }
};

template <class Epi, class Sched>
__device__ __forceinline__ void gemm_phase(LAS unsigned char* lds, const int K, const Sched& S, const Epi& E) {
    const int tid = threadIdx.x, wid = __builtin_amdgcn_readfirstlane(tid >> 6), lane = tid & 63, wr = wid >> 2, wc = wid & 3, fr = lane & 15, fq = lane >> 4;
    const int nt = K / BK;
    unsigned voffA[2], voffB[2];
#pragma unroll
    for (int i = 0; i < 2; ++i) { int R, C; stage_rc(tid * 16 + i * 8192, R, C); const int Rb = Epi::PERM ? ((R & ~31) + perm32(R & 31)) : R;
        voffA[i] = (unsigned)(R * K + C) * 2u; voffB[i] = (unsigned)(Rb * K + C) * 2u; }
    const size_t kstep = (size_t)(BK * 2);
    const size_t hstep = (size_t)HALF * K * 2;
    const unsigned ldsw = (unsigned)wid * 1024u;
    const int aoff = lds_byte(wr * 64 + fr, fq * 8), boff = lds_byte(wc * 32 + fr, fq * 8);
#define PG8_SA(b, h) (((b) * 2 + (h)) * HTB)
#define PG8_SB(b, h) ((4 + (b) * 2 + (h)) * HTB)
#define PG8_STAGE(bufoff, gbase, voff) do { _Pragma("unroll") for (int _i = 0; _i < 2; ++_i) \
        __builtin_amdgcn_global_load_lds((const unsigned*)((const char*)(gbase) + (voff)[_i]), (LAS unsigned*)(lds + (bufoff) + ldsw + _i * 8192), 16, 0, 0); } while (0)
#define PG8_LDA(dst, b, h) do { _Pragma("unroll") for (int m = 0; m < 4; ++m) _Pragma("unroll") for (int k = 0; k < 2; ++k) dst[m][k] = *(const LAS bf16x8*)(lds + PG8_SA(b, h) + aoff + m * 2048 + k * 1024); } while (0)
#define PG8_LDB(dst, b, h) do { _Pragma("unroll") for (int n = 0; n < 2; ++n) _Pragma("unroll") for (int k = 0; k < 2; ++k) dst[n][k] = *(const LAS bf16x8*)(lds + PG8_SB(b, h) + boff + n * 2048 + k * 1024); } while (0)
#define PG8_MMA(ai, bj, At, Bt) do { __builtin_amdgcn_s_setprio(1); _Pragma("unroll") for (int m = 0; m < 4; ++m) _Pragma("unroll") for (int n = 0; n < 2; ++n) _Pragma("unroll") for (int k = 0; k < 2; ++k) \
        acc[ai][bj][m][n] = __builtin_amdgcn_mfma_f32_16x16x32_bf16(Bt[n][k], At[m][k], acc[ai][bj][m][n], 0, 0, 0); __builtin_amdgcn_s_setprio(0); } while (0)
#define PG8_WAIT_V(n) asm volatile("s_waitcnt vmcnt(" #n ")" ::: "memory")
#define PG8_WAIT_L(n) asm volatile("s_waitcnt lgkmcnt(" #n ")" ::: "memory")
#define PG8_BAR __builtin_amdgcn_s_barrier()
#define PG8_SCHED __builtin_amdgcn_sched_barrier(0)
    Unit cur, nxt; int ui = 0;
    if (!S.next(0, cur)) return;
    f32x4 acc[2][2][4][2];
#pragma unroll
    for (int a = 0; a < 2; ++a)
#pragma unroll
        for (int b = 0; b < 2; ++b)
#pragma unroll
            for (int m = 0; m < 4; ++m)
#pragma unroll
                for (int n = 0; n < 2; ++n) acc[a][b][m][n] = (f32x4){0.f, 0.f, 0.f, 0.f};
    bf16x8 At[4][2], B0[2][2], B1[2][2];
    const char* cA = S.abase(cur); const char* cB = S.bbase(cur);
    PG8_STAGE(PG8_SB(0, 0), cB, voffB); PG8_STAGE(PG8_SA(0, 0), cA, voffA); PG8_STAGE(PG8_SB(0, 1), cB + hstep, voffB); PG8_STAGE(PG8_SA(0, 1), cA + hstep, voffA);
    if (wr == 1) PG8_BAR;
    PG8_WAIT_V(4); PG8_BAR;
    PG8_STAGE(PG8_SB(1, 0), cB + kstep, voffB); PG8_STAGE(PG8_SA(1, 0), cA + kstep, voffA); PG8_STAGE(PG8_SB(1, 1), cB + hstep + kstep, voffB);
    PG8_WAIT_V(6); PG8_BAR;
    for (;;) {
        const bool has_next = S.next(ui + 1, nxt);
        const char* nA = has_next ? S.abase(nxt) : cA; const char* nB = has_next ? S.bbase(nxt) : cB;
        for (int t = 0; t < nt; t += 2) {
            const bool last = (t == nt - 2);
            const char* a1 = cA + (size_t)(t + 1) * kstep;
            const char* a2 = last ? nA : cA + (size_t)(t + 2) * kstep; const char* b2 = last ? nB : cB + (size_t)(t + 2) * kstep;
            const char* a3 = a2 + kstep; const char* b3 = b2 + kstep;
            PG8_LDB(B0, 0, 0); PG8_SCHED; PG8_LDA(At, 0, 0); PG8_STAGE(PG8_SA(1, 1), a1 + hstep, voffA);
            PG8_WAIT_L(8); PG8_BAR; PG8_WAIT_L(0); PG8_MMA(0, 0, At, B0); PG8_BAR; PG8_SCHED;
            PG8_LDB(B1, 0, 1); PG8_STAGE(PG8_SB(0, 0), b2, voffB);
            PG8_BAR; PG8_WAIT_L(0); PG8_MMA(0, 1, At, B1); PG8_BAR;
            PG8_LDA(At, 0, 1); PG8_STAGE(PG8_SA(0, 0), a2, voffA);
            PG8_BAR; PG8_WAIT_L(0); PG8_MMA(1, 0, At, B0); PG8_BAR; PG8_SCHED;
            PG8_STAGE(PG8_SB(0, 1), b2 + hstep, voffB);
            PG8_WAIT_V(6); PG8_BAR; PG8_MMA(1, 1, At, B1); PG8_BAR;
            PG8_LDB(B0, 1, 0); PG8_SCHED; PG8_LDA(At, 1, 0); PG8_STAGE(PG8_SA(0, 1), a2 + hstep, voffA);
            PG8_WAIT_L(8); PG8_BAR; PG8_WAIT_L(0); PG8_MMA(0, 0, At, B0); PG8_BAR; PG8_SCHED;
            PG8_LDB(B1, 1, 1); PG8_STAGE(PG8_SB(1, 0), b3, voffB);
            PG8_BAR; PG8_WAIT_L(0); PG8_MMA(0, 1, At, B1); PG8_BAR;
            PG8_LDA(At, 1, 1); PG8_STAGE(PG8_SA(1, 0), a3, voffA);
            PG8_BAR; PG8_WAIT_L(0); PG8_MMA(1, 0, At, B0); PG8_BAR; PG8_SCHED;
            PG8_STAGE(PG8_SB(1, 1), b3 + hstep, voffB);
            PG8_WAIT_V(6); PG8_BAR; PG8_MMA(1, 1, At, B1); PG8_BAR;
        }
        E(acc, cur, wr, wc, fr, fq);
        if (!has_next) break;
        if (cur.part) {
#pragma unroll
            for (int a = 0; a < 2; ++a)
#pragma unroll
                for (int b = 0; b < 2; ++b)
#pragma unroll
                    for (int m = 0; m < 4; ++m)
#pragma unroll
                        for (int n = 0; n < 2; ++n) acc[a][b][m][n] = (f32x4){0.f, 0.f, 0.f, 0.f};
        }
        cur = nxt; cA = nA; cB = nB; ++ui;
    }
    PG8_WAIT_V(0);
    if (wr == 0) PG8_BAR;
    PG8_BAR;
#undef PG8_SA
#undef PG8_SB
#undef PG8_STAGE
#undef PG8_LDA
#undef PG8_LDB
#undef PG8_MMA
#undef PG8_WAIT_V
#undef PG8_WAIT_L
#undef PG8_BAR
#undef PG8_SCHED
}

template <class Epi, class Sched>
__device__ __forceinline__ void gemm_simple(const int K, const Sched& S, const Epi& E) {
    const int tid = threadIdx.x, wid = __builtin_amdgcn_readfirstlane(tid >> 6), lane = tid & 63, wr = wid >> 2, wc = wid & 3, fr = lane & 15, fq = lane >> 4;
    Unit cur;
    f32x4 acc[2][2][4][2];
#pragma unroll
    for (int a = 0; a < 2; ++a)
#pragma unroll
        for (int b = 0; b < 2; ++b)
#pragma unroll
            for (int m = 0; m < 4; ++m)
#pragma unroll
                for (int n = 0; n < 2; ++n) acc[a][b][m][n] = (f32x4){0.f, 0.f, 0.f, 0.f};
    for (int i = 0; S.next(i, cur); ++i) {
        const char* cA = S.abase(cur); const char* cB = S.bbase(cur);
        for (int k0 = 0; k0 < K; k0 += 32) {
#pragma unroll
            for (int ai = 0; ai < 2; ++ai)
#pragma unroll
                for (int bj = 0; bj < 2; ++bj) {
                    bf16x8 av[4], bv[2];
#pragma unroll
                    for (int m = 0; m < 4; ++m) av[m] = *(const bf16x8*)(cA + ((size_t)(ai * 128 + wr * 64 + m * 16 + fr) * K + k0 + fq * 8) * 2);
#pragma unroll
                    for (int n = 0; n < 2; ++n) { const int rho = n * 16 + fr, r = Epi::PERM ? perm32(rho) : rho; bv[n] = *(const bf16x8*)(cB + ((size_t)(bj * 128 + wc * 32 + r) * K + k0 + fq * 8) * 2); }
#pragma unroll
                    for (int m = 0; m < 4; ++m)
#pragma unroll
                        for (int n = 0; n < 2; ++n) acc[ai][bj][m][n] = __builtin_amdgcn_mfma_f32_16x16x32_bf16(bv[n], av[m], acc[ai][bj][m][n], 0, 0, 0);
                }
        }
        E(acc, cur, wr, wc, fr, fq);
        if (cur.part) {
#pragma unroll
            for (int a = 0; a < 2; ++a)
#pragma unroll
                for (int b = 0; b < 2; ++b)
#pragma unroll
                    for (int m = 0; m < 4; ++m)
#pragma unroll
                        for (int n = 0; n < 2; ++n) acc[a][b][m][n] = (f32x4){0.f, 0.f, 0.f, 0.f};
        }
    }
}
}
using pg8::Unit;

struct EpiIn {
    static constexpr bool PERM = true;
    bf16_t *PA, *PZA, *PUB, *PVB, *PGA, *PGB; float* vstat;
    __device__ __forceinline__ void operator()(f32x4 (&acc)[2][2][4][2], const Unit& u, int wr, int wc, int fr, int fq) const {
        const int row0 = u.pm * 256 + wr * 64 + fr, pn = u.pn, cw = wc * 32 + 8 * fq;
        if (pn < 8) {
            bf16_t* base = PA + pn * 128 + cw;
#pragma unroll
            for (int ai = 0; ai < 2; ++ai)
#pragma unroll
                for (int m = 0; m < 4; ++m) { const size_t row = row0 + ai * 128 + m * 16;
                    const f32x4 o0 = acc[ai][0][m][0] * sig4(acc[ai][1][m][0]), o1 = acc[ai][0][m][1] * sig4(acc[ai][1][m][1]);
                    *(u32x4*)(base + row * DM) = pack8(o0, o1); }
        } else if (pn >= 12 && pn < 20) {
            bf16_t* base = PUB + (pn - 12) * 128 + cw;
#pragma unroll
            for (int ai = 0; ai < 2; ++ai)
#pragma unroll
                for (int m = 0; m < 4; ++m) { const size_t row = row0 + ai * 128 + m * 16;
                    const f32x4 o0 = gelu4(acc[ai][0][m][0]) * silu4(acc[ai][1][m][0]), o1 = gelu4(acc[ai][0][m][1]) * silu4(acc[ai][1][m][1]);
                    *(u32x4*)(base + row * DM) = pack8(o0, o1); }
        } else if (pn >= 20 && pn < 24) {
            bf16_t* base = PVB + (pn - 20) * 256 + cw;
#pragma unroll
            for (int ai = 0; ai < 2; ++ai)
#pragma unroll
                for (int m = 0; m < 4; ++m) { const size_t row = row0 + ai * 128 + m * 16; float s = 0.f, q = 0.f;
#pragma unroll
                    for (int bj = 0; bj < 2; ++bj) { const u32x4 w = pack8(gelu4(acc[ai][bj][m][0]), gelu4(acc[ai][bj][m][1]));
                        *(u32x4*)(base + row * DM + bj * 128) = w;
#pragma unroll
                        for (int e = 0; e < 4; ++e) { const float a = bf_lo(w[e]), b = bf_hi(w[e]); s += a + b; q += a * a + b * b; } }
                    s += __shfl_xor(s, 16); s += __shfl_xor(s, 32); q += __shfl_xor(q, 16); q += __shfl_xor(q, 32);
                    if (fq == 0) *(f32x2*)(vstat + (row * 16 + (pn - 20) * 4 + wc) * 2) = (f32x2){s, q}; }
        } else if (pn < 12) {
            bf16_t* base = PZA + (pn - 8) * 256 + cw;
#pragma unroll
            for (int ai = 0; ai < 2; ++ai)
#pragma unroll
                for (int m = 0; m < 4; ++m) { const size_t row = row0 + ai * 128 + m * 16;
#pragma unroll
                    for (int bj = 0; bj < 2; ++bj) *(u32x4*)(base + row * DM + bj * 128) = pack8(silu4(acc[ai][bj][m][0]), silu4(acc[ai][bj][m][1])); }
        } else {
            bf16_t* base = (pn < 28 ? PGA + (pn - 24) * 256 : PGB + (pn - 28) * 256) + cw;
#pragma unroll
            for (int ai = 0; ai < 2; ++ai)
#pragma unroll
                for (int m = 0; m < 4; ++m) { const size_t row = row0 + ai * 128 + m * 16;
#pragma unroll
                    for (int bj = 0; bj < 2; ++bj) *(u32x4*)(base + row * DM + bj * 128) = pack8(sig4(acc[ai][bj][m][0]), sig4(acc[ai][bj][m][1])); }
        }
    }
};

struct EpiMerge {
    static constexpr bool PERM = true;
    const bf16_t *PGA, *PGB; bf16_t* MG;
    __device__ __forceinline__ void operator()(f32x4 (&acc)[2][2][4][2], const Unit& u, int wr, int wc, int fr, int fq) const {
        const int row0 = u.pm * 256 + wr * 64 + fr, col0 = u.pn * 256 + wc * 32 + 8 * fq;
#pragma unroll
        for (int ai = 0; ai < 2; ++ai)
#pragma unroll
            for (int m = 0; m < 4; ++m) { const size_t off = (size_t)(row0 + ai * 128 + m * 16) * DM + col0;
#pragma unroll
                for (int bj = 0; bj < 2; ++bj) {
                    const u32x4 gb = *(const u32x4*)(PGB + off + bj * 128);
                    const f32x4 b0 = (f32x4){bf_lo(gb.x), bf_hi(gb.x), bf_lo(gb.y), bf_hi(gb.y)}, b1 = (f32x4){bf_lo(gb.z), bf_hi(gb.z), bf_lo(gb.w), bf_hi(gb.w)};
                    if (u.part == 0) {
                        const u32x4 ga = *(const u32x4*)(PGA + off + bj * 128);
                        const f32x4 a0 = (f32x4){bf_lo(ga.x), bf_hi(ga.x), bf_lo(ga.y), bf_hi(ga.y)}, a1 = (f32x4){bf_lo(ga.z), bf_hi(ga.z), bf_lo(ga.w), bf_hi(ga.w)};
#pragma unroll
                        for (int e = 0; e < 4; ++e) { acc[ai][bj][m][0][e] *= a0[e] * __builtin_amdgcn_rcpf(fmaxf(b0[e], 1e-20f)); acc[ai][bj][m][1][e] *= a1[e] * __builtin_amdgcn_rcpf(fmaxf(b1[e], 1e-20f)); }
                    } else {
                        *(u32x4*)(MG + off + bj * 128) = pack8(acc[ai][bj][m][0] * b0, acc[ai][bj][m][1] * b1);
                    }
                } }
    }
};

struct EpiOut {
    static constexpr bool PERM = false;
    const float* x; const float* mod; float* out; float* xstat;
    __device__ __forceinline__ void operator()(f32x4 (&acc)[2][2][4][2], const Unit& u, int wr, int wc, int fr, int fq) const {
        const int row0 = u.pm * 256 + wr * 64 + fr, col0 = u.pn * 256 + wc * 32 + 4 * fq;
        const float* gate = mod + (size_t)(u.pm >> 4) * 3072 + 2048 + col0;
        f32x4 gv[2][2];
#pragma unroll
        for (int bj = 0; bj < 2; ++bj)
#pragma unroll
            for (int n = 0; n < 2; ++n) gv[bj][n] = *(const f32x4*)(gate + bj * 128 + n * 16);
#pragma unroll
        for (int ai = 0; ai < 2; ++ai)
#pragma unroll
            for (int m = 0; m < 4; ++m) { const size_t row = row0 + ai * 128 + m * 16; const size_t off = row * DM + col0; float q = 0.f;
#pragma unroll
                for (int bj = 0; bj < 2; ++bj)
#pragma unroll
                    for (int n = 0; n < 2; ++n) { const f32x4 xv = *(const f32x4*)(x + off + bj * 128 + n * 16); const f32x4 o = xv + gv[bj][n] * acc[ai][bj][m][n];
                        *(f32x4*)(out + off + bj * 128 + n * 16) = o; q += (o[0] * o[0] + o[1] * o[1]) + (o[2] * o[2] + o[3] * o[3]); }
                q += __shfl_xor(q, 16); q += __shfl_xor(q, 32);
                if (fq == 0) xstat[row * 16 + u.pn * 4 + wc] = q; }
    }
};

__device__ __forceinline__ int win_dst_row(int ns) {
    const int seg = ns >> 10, i = ns & 1023, j = i >> 7, r = i & 127;
    switch (seg) {
        case 0: return j * 256 + r;
        case 1: return j * 256 + 128 + r;
        case 2: return 2048 + i;
        case 3: return (12 + j) * 256 + r;
        case 5: return (12 + j) * 256 + 128 + r;
        case 4: return 5120 + i;
        case 6: return 6144 + i;
        default: return 7168 + i;
    }
}
__device__ void phase_prep(LAS unsigned char* lds, const Args& a, int G, int bid) {
    const int tid = threadIdx.x;
    unsigned char* ws = a.ws;
    { bf16_t* WSB = (bf16_t*)(ws + WS_WSB);
      for (int i = bid * NTHREADS + tid; i < 8 * 128 * 128 / 2; i += G * NTHREADS) { const int e = i * 2, t = (e >> 7) & 127, s = e & 127;
          const f32x2 v = *(const f32x2*)(a.w_sgu + e); ((unsigned*)WSB)[i] = cvt_pk_bf16(s <= t ? v.x : 0.f, (s + 1) <= t ? v.y : 0.f); } }
    constexpr int N_MOD = 48, N_TR = 2048 + 768;
    for (int item = bid; item < N_MOD + N_TR; item += G) {
        if (item < N_MOD) {
            LAS float* cs = (LAS float*)lds;
            LAS float* red = (LAS float*)(lds + 32768);
            for (int i = tid; i < 8 * 1024; i += NTHREADS) cs[i] = a.c[i];
            __syncthreads();
            const int n = tid & 63, kq = tid >> 6, n0 = item * 64;
            float s[8] = {0.f, 0.f, 0.f, 0.f, 0.f, 0.f, 0.f, 0.f};
            for (int k = kq * 128; k < kq * 128 + 128; ++k) { const float w = a.w_ada[(size_t)k * 3072 + n0 + n];
#pragma unroll
                for (int b = 0; b < 8; ++b) s[b] += cs[b * 1024 + k] * w; }
#pragma unroll
            for (int b = 0; b < 8; ++b) red[(kq * 8 + b) * 64 + n] = s[b];
            __syncthreads();
            { const int b = tid >> 6; float t = 0.f;
#pragma unroll
              for (int q = 0; q < 8; ++q) t += red[(q * 8 + b) * 64 + n];
              ((float*)(ws + WS_MOD))[b * 3072 + n0 + n] = t + a.b_ada[n0 + n]; }
            __syncthreads();
        } else {
            const int t = item - N_MOD; const float* src; bf16_t* dst; int ld;
            if (t < 2048) { const int kt = t & 15, ntile = t >> 4, ns0 = ntile * 64, k0 = kt * 64; src = a.w_in + (size_t)k0 * NIN + ns0; ld = NIN; dst = (bf16_t*)(ws + WS_WT1) + (size_t)win_dst_row(ns0) * DM + k0; }
            else { const int t2 = t - 2048, which = t2 >> 8, tt = t2 & 255, kt = tt & 15, ntile = tt >> 4, ns0 = ntile * 64, k0 = kt * 64;
                const float* w = which == 0 ? a.w_conv_out : (which == 1 ? a.w_sgu_out : a.w_o);
                src = w + (size_t)k0 * DM + ns0; ld = DM; dst = (bf16_t*)(ws + (which == 0 ? WS_WT2 : (which == 1 ? WS_WT3 : WS_WT4))) + (size_t)ns0 * DM + k0; }
            LAS float* T = (LAS float*)lds;
            { const int cc = tid & 63, r0 = tid >> 6;
#pragma unroll
              for (int i = 0; i < 8; ++i) { const int r = r0 + 8 * i; T[r * 65 + cc] = src[(size_t)r * ld + cc]; } }
            __syncthreads();
            { const int n = tid >> 3, kk = (tid & 7) * 8; float v[8];
#pragma unroll
              for (int j = 0; j < 8; ++j) v[j] = T[(kk + j) * 65 + n];
              u32x4 w; w.x = cvt_pk_bf16(v[0], v[1]); w.y = cvt_pk_bf16(v[2], v[3]); w.z = cvt_pk_bf16(v[4], v[5]); w.w = cvt_pk_bf16(v[6], v[7]);
              *(u32x4*)(dst + (size_t)n * DM + kk) = w; }
            __syncthreads();
        }
    }
}

__device__ void phase_h(const Args& a, int G, int bid) {
    const int tid = threadIdx.x, wave = tid >> 6, lane = tid & 63;
    const float* mod = (const float*)(a.ws + WS_MOD); bf16_t* H = (bf16_t*)(a.ws + WS_H);
    const int rpw = (MT + G * 8 - 1) / (G * 8);
    const int rbeg = (bid * 8 + wave) * rpw;
    for (int r = 0; r < rpw; ++r) { const int row = rbeg + r; if (row >= MT) break;
        const int b = row >> 12; const float* xr = a.x + (size_t)row * DM;
        f32x4 v[4]; float ss = 0.f;
#pragma unroll
        for (int i = 0; i < 2; ++i)
#pragma unroll
            for (int h = 0; h < 2; ++h) { v[i * 2 + h] = *(const f32x4*)(xr + i * 512 + lane * 8 + h * 4); const f32x4 t = v[i * 2 + h]; ss += (t[0] * t[0] + t[1] * t[1]) + (t[2] * t[2] + t[3] * t[3]); }
        ss = wave_sum(ss);
        const float rstd = rsqrtf(ss * (1.0f / DM) + EPS);
#pragma unroll
        for (int i = 0; i < 2; ++i) { const int col = i * 512 + lane * 8; f32x4 o[2];
#pragma unroll
            for (int h = 0; h < 2; ++h) { const f32x4 g = *(const f32x4*)(a.g_pre + col + h * 4), sc = *(const f32x4*)(mod + b * 3072 + 1024 + col + h * 4), sh = *(const f32x4*)(mod + b * 3072 + col + h * 4);
                o[h] = ((v[i * 2 + h] * rstd) * g) * (sc + 1.0f) + sh; }
            *(u32x4*)(H + (size_t)row * DM + col) = pack8(o[0], o[1]); }
    }
}

__device__ void phase_mixA(LAS unsigned char* lds, const Args& a, int G, int bid) {
    const int tid = threadIdx.x, wave = tid >> 6, lane = tid & 63;
    const unsigned* PAu = (const unsigned*)(a.ws + WS_PA); bf16_t* PZA = (bf16_t*)(a.ws + WS_PZA);
    LAS float* Y = (LAS float*)lds;
    f32x2 w[31];
#pragma unroll
    for (int j = 0; j < 31; ++j) w[j] = *(const f32x2*)(a.conv_w + j * DM + 2 * tid);
    const f32x2 cb = *(const f32x2*)(a.conv_b + 2 * tid);
    for (int unit = bid; unit < MT / 128; unit += G) {
        const int t0 = unit * 128; const bool first = (t0 & (SEQ - 1)) == 0;
        f32x2 ring[32];
        ring[0] = (f32x2){0.f, 0.f}; ring[1] = (f32x2){0.f, 0.f};
#pragma unroll
        for (int s = 2; s < 32; ++s) { if (first) ring[s] = (f32x2){0.f, 0.f}; else { const unsigned u = PAu[(size_t)(t0 - 32 + s) * 512 + tid]; ring[s] = (f32x2){bf_lo(u), bf_hi(u)}; } }
        unsigned pf[32];
#pragma unroll
        for (int s = 0; s < 32; ++s) pf[s] = PAu[(size_t)(t0 + s) * 512 + tid];
#pragma unroll 1
        for (int sub = 0; sub < 4; ++sub) {
#pragma unroll
            for (int s = 0; s < 32; ++s) { ring[s] = (f32x2){bf_lo(pf[s]), bf_hi(pf[s])}; f32x2 y = cb;
#pragma unroll
                for (int j = 0; j < 31; ++j) y += w[j] * ring[(s - 30 + j) & 31];
                *(LAS f32x2*)(Y + s * DM + 2 * tid) = y; }
            if (sub < 3) {
#pragma unroll
                for (int s = 0; s < 32; ++s) pf[s] = PAu[(size_t)(t0 + (sub + 1) * 32 + s) * 512 + tid];
            }
            __syncthreads();
#pragma unroll 1
            for (int qq = 0; qq < 4; ++qq) { const int tok = wave + 8 * qq; const size_t row = (size_t)t0 + sub * 32 + tok;
                f32x4 y[4];
#pragma unroll
                for (int hh = 0; hh < 2; ++hh)
#pragma unroll
                    for (int h = 0; h < 2; ++h) y[hh * 2 + h] = *(const LAS f32x4*)(Y + tok * DM + hh * 512 + lane * 8 + h * 4);
                float s = 0.f;
#pragma unroll
                for (int i = 0; i < 4; ++i) s += (y[i][0] + y[i][1]) + (y[i][2] + y[i][3]);
                s = wave_sum(s); const float mean = s * (1.0f / DM); float q = 0.f;
#pragma unroll
                for (int i = 0; i < 4; ++i) { const f32x4 d = y[i] - mean; q += (d[0] * d[0] + d[1] * d[1]) + (d[2] * d[2] + d[3] * d[3]); }
                q = wave_sum(q); const float rstd = rsqrtf(q * (1.0f / DM) + EPS);
#pragma unroll
                for (int hh = 0; hh < 2; ++hh) { const int col = hh * 512 + lane * 8; bf16_t* zp = PZA + row * DM + col; const u32x4 z = *(const u32x4*)zp; f32x4 o[2];
#pragma unroll
                    for (int h = 0; h < 2; ++h) { const f32x4 g = *(const f32x4*)(a.conv_ln_g + col + h * 4), bb = *(const f32x4*)(a.conv_ln_b + col + h * 4);
                        const f32x4 zz = h == 0 ? (f32x4){bf_lo(z.x), bf_hi(z.x), bf_lo(z.y), bf_hi(z.y)} : (f32x4){bf_lo(z.z), bf_hi(z.z), bf_lo(z.w), bf_hi(z.w)};
                        o[h] = silu4(((y[hh * 2 + h] - mean) * rstd) * g + bb) * zz; }
                    *(u32x4*)zp = pack8(o[0], o[1]); }
            }
            __syncthreads();
        }
    }
}

__device__ void phase_mixB(LAS unsigned char* lds, const Args& a, int G, int bid) {
    const int tid = threadIdx.x, wave = __builtin_amdgcn_readfirstlane(tid >> 6), lane = tid & 63, fr = lane & 15, fq = lane >> 4;
    const unsigned* PVu = (const unsigned*)(a.ws + WS_PVB); bf16_t* PUB = (bf16_t*)(a.ws + WS_PUB);
    const float* vstat = (const float*)(a.ws + WS_VST); const bf16_t* WSB = (const bf16_t*)(a.ws + WS_WSB);
    LAS float* ST = (LAS float*)lds;
    LAS unsigned char* VT = lds + 1024;
    constexpr int VS = 272;
    for (int ch = bid; ch < MT / 128; ch += G) {
        const int t0 = ch * 128;
        if (tid < 128) { const float* p = vstat + (size_t)(t0 + tid) * 32; float s = 0.f, q = 0.f;
#pragma unroll
            for (int i = 0; i < 8; ++i) { const f32x4 v = *(const f32x4*)(p + i * 4); s += v[0] + v[2]; q += v[1] + v[3]; }
            const float mean = s * (1.0f / DM), var = fmaxf(q * (1.0f / DM) - mean * mean, 0.f);
            ST[tid * 2] = mean; ST[tid * 2 + 1] = rsqrtf(var + EPS); }
        __syncthreads();
#pragma unroll 1
        for (int h = 0; h < 8; ++h) {
#pragma unroll
            for (int it = 0; it < 2; ++it) { const int s0 = (wave * 2 + it) * 8, d0 = 2 * lane, chn = h * 128 + d0;
                const f32x2 g = *(const f32x2*)(a.sgu_ln_g + chn), bb = *(const f32x2*)(a.sgu_ln_b + chn);
                unsigned u[8];
#pragma unroll
                for (int j = 0; j < 8; ++j) u[j] = PVu[((size_t)(t0 + s0 + j) * DM + h * 128) / 2 + lane];
                float n0[8], n1[8];
#pragma unroll
                for (int j = 0; j < 8; ++j) { const float mean = ST[(s0 + j) * 2], rstd = ST[(s0 + j) * 2 + 1];
                    n0[j] = ((bf_lo(u[j]) - mean) * rstd) * g.x + bb.x; n1[j] = ((bf_hi(u[j]) - mean) * rstd) * g.y + bb.y; }
                u32x4 w0, w1;
                w0.x = cvt_pk_bf16(n0[0], n0[1]); w0.y = cvt_pk_bf16(n0[2], n0[3]); w0.z = cvt_pk_bf16(n0[4], n0[5]); w0.w = cvt_pk_bf16(n0[6], n0[7]);
                w1.x = cvt_pk_bf16(n1[0], n1[1]); w1.y = cvt_pk_bf16(n1[2], n1[3]); w1.z = cvt_pk_bf16(n1[4], n1[5]); w1.w = cvt_pk_bf16(n1[6], n1[7]);
                *(LAS u32x4*)(VT + d0 * VS + s0 * 2) = w0; *(LAS u32x4*)(VT + (d0 + 1) * VS + s0 * 2) = w1; }
            __syncthreads();
            f32x4 acc[8];
#pragma unroll
            for (int n = 0; n < 8; ++n) acc[n] = (f32x4){0.f, 0.f, 0.f, 0.f};
            const int nk = (16 * wave + 15) / 32 + 1;
            for (int kk = 0; kk < nk; ++kk) { const bf16x8 A = *(const bf16x8*)(WSB + (size_t)(h * 128 + 16 * wave + fr) * 128 + kk * 32 + fq * 8);
#pragma unroll
                for (int n = 0; n < 8; ++n) { const bf16x8 B = *(const LAS bf16x8*)(VT + (16 * n + fr) * VS + (kk * 32 + fq * 8) * 2);
                    acc[n] = __builtin_amdgcn_mfma_f32_16x16x32_bf16(B, A, acc[n], 0, 0, 0); } }
            { const int t = 16 * wave + fr; const float bias = a.b_sgu[h * 128 + t]; bf16_t* up = PUB + (size_t)(t0 + t) * DM + h * 128 + 4 * fq;
#pragma unroll
              for (int n = 0; n < 8; ++n) { const u32x2 uu = *(const u32x2*)(up + 16 * n); u32x2 o;
                  o.x = cvt_pk_bf16((acc[n][0] + bias) * bf_lo(uu.x), (acc[n][1] + bias) * bf_hi(uu.x)); o.y = cvt_pk_bf16((acc[n][2] + bias) * bf_lo(uu.y), (acc[n][3] + bias) * bf_hi(uu.y));
                  *(u32x2*)(up + 16 * n) = o; } }
            __syncthreads();
        }
    }
}

__device__ void phase_final(const Args& a, int G, int bid) {
    const int tid = threadIdx.x, wave = tid >> 6, lane = tid & 63;
    const float* xstat = (const float*)(a.ws + WS_XST);
    f32x4 g[4];
#pragma unroll
    for (int i = 0; i < 4; ++i) g[i] = *(const f32x4*)(a.g_final + i * 256 + lane * 4);
    for (int row = bid * 8 + wave; row < MT; row += G * 8) {
        float q = 0.f;
#pragma unroll
        for (int i = 0; i < 4; ++i) { const f32x4 v = *(const f32x4*)(xstat + (size_t)row * 16 + i * 4); q += (v[0] + v[1]) + (v[2] + v[3]); }
        const float rstd = rsqrtf(q * (1.0f / DM) + EPS);
        float* o = a.out + (size_t)row * DM;
#pragma unroll
        for (int i = 0; i < 4; ++i) { const f32x4 v = *(const f32x4*)(o + i * 256 + lane * 4); *(f32x4*)(o + i * 256 + lane * 4) = (v * rstd) * g[i]; }
    }
}

__global__ void __launch_bounds__(NTHREADS, 2) fwd_kernel(Args a) {
    extern __shared__ __attribute__((aligned(16))) unsigned char shm[];
    LAS unsigned char* lds = (LAS unsigned char*)shm;
    cg::grid_group grid = cg::this_grid();
    const int G = gridDim.x, bid = blockIdx.x;
    const int lo = a.ph_lo, hi = a.ph_hi;
    unsigned char* ws = a.ws;
#define IN(k) (lo <= (k) && (k) < hi)
#define SEAM(k) do { if (IN(k) && IN((k) + 1)) grid.sync(); } while (0)
    if (IN(0)) phase_prep(lds, a, G, bid);
    SEAM(0);
    if (IN(1)) phase_h(a, G, bid);
    SEAM(1);
    if (IN(2)) {
        pg8::OrderStd S; S.init(ws + WS_H, ws + WS_WT1, MT, NIN, DM, G, bid);
        EpiIn E{(bf16_t*)(ws + WS_PA), (bf16_t*)(ws + WS_PZA), (bf16_t*)(ws + WS_PUB), (bf16_t*)(ws + WS_PVB), (bf16_t*)(ws + WS_PGA), (bf16_t*)(ws + WS_PGB), (float*)(ws + WS_VST)};
        if (GEMM_SIMPLE & 1) pg8::gemm_simple<EpiIn, pg8::OrderStd>(DM, S, E); else pg8::gemm_phase<EpiIn, pg8::OrderStd>(lds, DM, S, E);
    }
    SEAM(2);
    if (IN(3)) { phase_mixA(lds, a, G, bid); __syncthreads(); phase_mixB(lds, a, G, bid); }
    SEAM(3);
    if (IN(4)) {
        pg8::OrderDual S; S.init(ws + WS_PZA, ws + WS_PUB, ws + WS_WT2, ws + WS_WT3, MT, DM, DM, G, bid);
        EpiMerge E{(const bf16_t*)(ws + WS_PGA), (const bf16_t*)(ws + WS_PGB), (bf16_t*)(ws + WS_H)};
        if (GEMM_SIMPLE & 2) pg8::gemm_simple<EpiMerge, pg8::OrderDual>(DM, S, E); else pg8::gemm_phase<EpiMerge, pg8::OrderDual>(lds, DM, S, E);
    }
    SEAM(4);
    if (IN(5)) {
        pg8::OrderStd S; S.init(ws + WS_H, ws + WS_WT4, MT, DM, DM, G, bid);
        EpiOut E{a.x, (const float*)(ws + WS_MOD), a.out, (float*)(ws + WS_XST)};
        if (GEMM_SIMPLE & 4) pg8::gemm_simple<EpiOut, pg8::OrderStd>(DM, S, E); else pg8::gemm_phase<EpiOut, pg8::OrderStd>(lds, DM, S, E);
    }
    SEAM(5);
    if (IN(6)) phase_final(a, G, bid);
#undef IN
#undef SEAM
}

extern "C" void kernel_launch(void* const* d_in, const int* in_sizes, int n_in, void* d_out, int out_size, void* d_ws, size_t ws_size, hipStream_t stream) {
    static int grid = 0;
    if (grid == 0) {
        if (n_in != 18 || out_size != MT * DM || ws_size < WS_END) { fprintf(stderr, "kernel_launch: unexpected shapes (n_in %d out %d ws %zu)\n", n_in, out_size, ws_size); grid = -1; return; }
        int dev = 0, cus = 0, per_cu = 0;
        (void)hipGetDevice(&dev); (void)hipDeviceGetAttribute(&cus, hipDeviceAttributeMultiprocessorCount, dev);
        if (hipFuncSetAttribute((const void*)fwd_kernel, hipFuncAttributeMaxDynamicSharedMemorySize, LDS_BYTES) != hipSuccess) { fprintf(stderr, "kernel_launch: hipFuncSetAttribute failed\n"); grid = -1; return; }
        if (hipOccupancyMaxActiveBlocksPerMultiprocessor(&per_cu, (const void*)fwd_kernel, NTHREADS, LDS_BYTES) != hipSuccess || per_cu < 1) { fprintf(stderr, "kernel_launch: occupancy query gave %d\n", per_cu); per_cu = 1; }
        (void)hipGetLastError();
        grid = cus * per_cu;
    }
    if (grid < 0) return;
    Args a{};
    { const float* p[18]; for (int i = 0; i < 18; ++i) p[i] = (const float*)d_in[i];
      a.x = p[0]; a.c = p[1]; a.w_ada = p[2]; a.b_ada = p[3]; a.g_pre = p[4]; a.w_in = p[5]; a.conv_w = p[6]; a.conv_b = p[7]; a.conv_ln_g = p[8]; a.conv_ln_b = p[9]; a.w_conv_out = p[10];
      a.sgu_ln_g = p[11]; a.sgu_ln_b = p[12]; a.w_sgu = p[13]; a.b_sgu = p[14]; a.w_sgu_out = p[15]; a.w_o = p[16]; a.g_final = p[17]; }
    a.out = (float*)d_out; a.ws = (unsigned char*)d_ws;
#if MK_SINGLE
    a.ph_lo = 0; a.ph_hi = 7;
    void* args[] = {&a};
    hipError_t e = hipLaunchCooperativeKernel((const void*)fwd_kernel, dim3(grid), dim3(NTHREADS), args, LDS_BYTES, stream);
    if (e != hipSuccess) fprintf(stderr, "cooperative launch failed: %s (grid %d)\n", hipGetErrorString(e), grid);
#else
    for (int p = 0; p < 7; ++p) { a.ph_lo = p; a.ph_hi = p + 1; hipLaunchKernelGGL(fwd_kernel, dim3(grid), dim3(NTHREADS), LDS_BYTES, stream, a); }
#endif
}
```

```cpp
#include <hip/hip_runtime.h>
#include <hip/hip_cooperative_groups.h>
#include <cstdio>
namespace cg = cooperative_groups;


#ifndef P3SEL
#define P3SEL 3
#endif
#ifndef STAG1
#define STAG1 0
#endif
#define LAS __attribute__((address_space(3)))
typedef unsigned short bf16_t;
typedef short bf16x8 __attribute__((ext_vector_type(8)));
typedef float f32x4 __attribute__((ext_vector_type(4)));
typedef float f32x2 __attribute__((ext_vector_type(2)));
typedef unsigned u32x4 __attribute__((ext_vector_type(4)));
typedef unsigned u32x2 __attribute__((ext_vector_type(2)));

constexpr int DM = 1024, NB = 8, SEQ = 4096, MT = NB * SEQ, NIN = 8192;
constexpr float EPS = 1e-6f;
constexpr int NTHREADS = 512;
constexpr int LDS_BYTES = 128 * 1024 + 4096;

constexpr size_t MB = 1024 * 1024;
constexpr size_t WS_WT1 = 0;
constexpr size_t WS_WT2 = 16 * MB;
constexpr size_t WS_WT3 = 18 * MB;
constexpr size_t WS_WT4 = 20 * MB;
constexpr size_t WS_WSB = 22 * MB;
constexpr size_t WS_MOD = 23 * MB;
constexpr size_t WS_VST = 24 * MB;
constexpr size_t WS_XST = 28 * MB;
constexpr size_t WS_BAR = 30 * MB;
constexpr size_t WS_H   = 32 * MB;
constexpr size_t WS_PA  = 96 * MB;
constexpr size_t WS_PZA = 160 * MB;
constexpr size_t WS_PUB = 224 * MB;
constexpr size_t WS_PVB = 288 * MB;
constexpr size_t WS_PGA = 352 * MB;
constexpr size_t WS_PGB = 416 * MB;
constexpr size_t WS_END = 480 * MB;

struct Args {
    const float *x, *c, *w_ada, *b_ada, *g_pre, *w_in, *conv_w, *conv_b, *conv_ln_g, *conv_ln_b, *w_conv_out,
        *sgu_ln_g, *sgu_ln_b, *w_sgu, *b_sgu, *w_sgu_out, *w_o, *g_final;
    float* out; unsigned char* ws;
};

typedef __bf16 bf16x2_t __attribute__((ext_vector_type(2)));
__device__ __forceinline__ unsigned cvt_pk_bf16(float lo, float hi) { const f32x2 v = {lo, hi}; const bf16x2_t r = __builtin_convertvector(v, bf16x2_t); return __builtin_bit_cast(unsigned, r); }
__device__ __forceinline__ float bf_lo(unsigned u) { return __uint_as_float(u << 16); }
__device__ __forceinline__ float bf_hi(unsigned u) { return __uint_as_float(u & 0xffff0000u); }
__device__ __forceinline__ float wave_sum(float v) {
#pragma unroll
    for (int o = 32; o >= 1; o >>= 1) v += __shfl_xor(v, o);
    return v;
}
__device__ __forceinline__ float sigmoidf_(float x) { return __builtin_amdgcn_rcpf(1.0f + __builtin_amdgcn_exp2f(x * -1.44269504f)); }
__device__ __forceinline__ float siluf_(float x) { return x * sigmoidf_(x); }
__device__ __forceinline__ f32x2 gelu_pk(f32x2 v) {
    const f32x2 av = __builtin_elementwise_abs(v), d = av * 0.2316418882f + 1.0f;
    f32x2 t; t.x = __builtin_amdgcn_rcpf(d.x); t.y = __builtin_amdgcn_rcpf(d.y);
    f32x2 q = t * 0.5307027145f + (-0.7265760135f); q = q * t + 0.7107068705f; q = q * t + (-0.142248368f); q = q * t + 0.127414796f; q = q * t;
    const f32x2 s = (v * v) * (-0.72134752044f);
    f32x2 e; e.x = __builtin_amdgcn_exp2f(s.x); e.y = __builtin_amdgcn_exp2f(s.y);
    const f32x2 m = v * (q * e), r = v - m;
    f32x2 o; o.x = v.x < 0.f ? m.x : r.x; o.y = v.y < 0.f ? m.y : r.y; return o;
}
__device__ __forceinline__ f32x4 gelu4(f32x4 v) { f32x2 a = gelu_pk((f32x2){v[0], v[1]}), b = gelu_pk((f32x2){v[2], v[3]}); return (f32x4){a.x, a.y, b.x, b.y}; }
__device__ __forceinline__ f32x4 sig4(f32x4 v) { return (f32x4){sigmoidf_(v[0]), sigmoidf_(v[1]), sigmoidf_(v[2]), sigmoidf_(v[3])}; }
__device__ __forceinline__ f32x4 silu4(f32x4 v) { return v * sig4(v); }
__device__ __forceinline__ u32x4 pack8(f32x4 a, f32x4 b) { u32x4 w; w.x = cvt_pk_bf16(a[0], a[1]); w.y = cvt_pk_bf16(a[2], a[3]); w.z = cvt_pk_bf16(b[0], b[1]); w.w = cvt_pk_bf16(b[2], b[3]); return w; }

namespace pg8 {
constexpr int BM = 256, BK = 64, HALF = 128, HTB = HALF * BK * 2, STAGE_BYTES = 8 * HTB, NXCD = 8, WGM = 8;
__device__ __forceinline__ int lds_byte(int r, int c) { const int st = (r >> 4) * 2 + (c >> 5), rr = r & 15, cc = c & 31, ob = rr * 64 + cc * 2; return st * 1024 + (ob ^ (((ob >> 9) & 1) << 5)); }
__device__ __forceinline__ void stage_rc(int b, int& R, int& C) { const int st = b / 1024, sb = b % 1024, swz = sb ^ (((sb >> 9) & 1) << 5); R = (st >> 1) * 16 + swz / 64; C = (st & 1) * 32 + (swz % 64) / 2; }
__device__ __forceinline__ int perm32(int rho) { const int n = rho >> 4, i = rho & 15; return 8 * (i >> 2) + 4 * n + (i & 3); }

struct Unit { int pm, pn, part; };

__device__ __forceinline__ void tile_of(int wgid_in, int nM, int nN, int nwg, Unit& u) {
    int wgid = wgid_in; { const int q = nwg / NXCD, r = nwg % NXCD, xcd = wgid % NXCD, off = wgid / NXCD; wgid = (xcd < r ? xcd * (q + 1) : r * (q + 1) + (xcd - r) * q) + off; }
    const int nig = WGM * nN, gid = wgid / nig, fm = gid * WGM, gsz = (nM - fm) < WGM ? (nM - fm) : WGM;
    u.pm = fm + ((wgid % nig) % gsz); u.pn = (wgid % nig) / gsz;
}
struct OrderStd {
    int nM, nN, nwg, G, c; const char* A; const char* B; size_t tstep;
    __device__ void init(const void* A_, const void* B_, int M, int N, int K, int G_, int c_) { A = (const char*)A_; B = (const char*)B_; nM = M / BM; nN = N / BM; nwg = nM * nN; G = G_; c = c_; tstep = (size_t)BM * K * 2; }
    __device__ bool next(int i, Unit& u) const { const long L = (long)i * G + c; if (L >= nwg) return false; tile_of((int)L, nM, nN, nwg, u); u.part = 1; return true; }
    __device__ __forceinline__ const char* abase(const Unit& u) const { return A + (size_t)u.pm * tstep; }
    __device__ __forceinline__ const char* bbase(const Unit& u) const { return B + (size_t)u.pn * tstep; }
};
struct OrderDual {
    int nM, nN, nwg, G, c; const char *A0, *A1, *B0, *B1; size_t tstep;
    __device__ void init(const void* A0_, const void* A1_, const void* B0_, const void* B1_, int M, int N, int K, int G_, int c_) { A0 = (const char*)A0_; A1 = (const char*)A1_; B0 = (const char*)B0_; B1 = (const char*)B1_; nM = M / BM; nN = N / BM; nwg = nM * nN; G = G_; c = c_; tstep = (size_t)BM * K * 2; }
    __device__ bool next(int i, Unit& u) const { const long L = (long)(i >> 1) * G + c; if (L >= nwg) return false; tile_of((int)L, nM, nN, nwg, u); u.part = i & 1; return true; }
    __device__ __forceinline__ const char* abase(const Unit& u) const { return (u.part ? A1 : A0) + (size_t)u.pm * tstep; }
    __device__ __forceinline__ const char* bbase(const Unit& u) const { return (u.part ? B1 : B0) + (size_t)u.pn * tstep; }
};

template <class Epi, class Sched>
__device__ __forceinline__ void gemm_phase(LAS unsigned char* lds, const int K, const Sched& S, const Epi& E, const int stag_ticks = 0) {
    if (stag_ticks > 0) { const int grp = (blockIdx.x >> 3) & 3; if (grp) { const unsigned long long t0 = __builtin_amdgcn_s_memrealtime(); while (__builtin_amdgcn_s_memrealtime() - t0 < (unsigned long long)(grp * stag_ticks)) __builtin_amdgcn_s_sleep(16); } }
    const int tid = threadIdx.x, wid = __builtin_amdgcn_readfirstlane(tid >> 6), lane = tid & 63, wr = wid >> 2, wc = wid & 3, fr = lane & 15, fq = lane >> 4;
    const int nt = K / BK;
    unsigned voffA[2], voffB[2];
#pragma unroll
    for (int i = 0; i < 2; ++i) { int R, C; stage_rc(tid * 16 + i * 8192, R, C); const int Rb = Epi::PERM ? ((R & ~31) + perm32(R & 31)) : R;
        voffA[i] = (unsigned)(R * K + C) * 2u; voffB[i] = (unsigned)(Rb * K + C) * 2u; }
    const size_t kstep = (size_t)(BK * 2);
    const size_t hstep = (size_t)HALF * K * 2;
    const unsigned ldsw = (unsigned)wid * 1024u;
    const int aoff = lds_byte(wr * 64 + fr, fq * 8), boff = lds_byte(wc * 32 + fr, fq * 8);
#define PG8_SA(b, h) (((b) * 2 + (h)) * HTB)
#define PG8_SB(b, h) ((4 + (b) * 2 + (h)) * HTB)
#define PG8_STAGE(bufoff, gbase, voff) do { _Pragma("unroll") for (int _i = 0; _i < 2; ++_i) \
        __builtin_amdgcn_global_load_lds((const unsigned*)((const char*)(gbase) + (voff)[_i]), (LAS unsigned*)(lds + (bufoff) + ldsw + _i * 8192), 16, 0, 0); } while (0)
#define PG8_LDA(dst, b, h) do { _Pragma("unroll") for (int m = 0; m < 4; ++m) _Pragma("unroll") for (int k = 0; k < 2; ++k) dst[m][k] = *(const LAS bf16x8*)(lds + PG8_SA(b, h) + aoff + m * 2048 + k * 1024); } while (0)
#define PG8_LDB(dst, b, h) do { _Pragma("unroll") for (int n = 0; n < 2; ++n) _Pragma("unroll") for (int k = 0; k < 2; ++k) dst[n][k] = *(const LAS bf16x8*)(lds + PG8_SB(b, h) + boff + n * 2048 + k * 1024); } while (0)
#define PG8_MMA(ai, bj, At, Bt) do { __builtin_amdgcn_s_setprio(1); _Pragma("unroll") for (int m = 0; m < 4; ++m) _Pragma("unroll") for (int n = 0; n < 2; ++n) _Pragma("unroll") for (int k = 0; k < 2; ++k) \
        acc[ai][bj][m][n] = __builtin_amdgcn_mfma_f32_16x16x32_bf16(Bt[n][k], At[m][k], acc[ai][bj][m][n], 0, 0, 0); __builtin_amdgcn_s_setprio(0); } while (0)
#define PG8_WAIT_V(n) asm volatile("s_waitcnt vmcnt(" #n ")" ::: "memory")
#define PG8_WAIT_L(n) asm volatile("s_waitcnt lgkmcnt(" #n ")" ::: "memory")
#define PG8_BAR __builtin_amdgcn_s_barrier()
#define PG8_SCHED __builtin_amdgcn_sched_barrier(0)
    Unit cur, nxt; int ui = 0;
    if (!S.next(0, cur)) return;
    f32x4 acc[2][2][4][2];
#pragma unroll
    for (int a = 0; a < 2; ++a)
#pragma unroll
        for (int b = 0; b < 2; ++b)
#pragma unroll
            for (int m = 0; m < 4; ++m)
#pragma unroll
                for (int n = 0; n < 2; ++n) acc[a][b][m][n] = (f32x4){0.f, 0.f, 0.f, 0.f};
    bf16x8 At[4][2], B0[2][2], B1[2][2];
    const char* cA = S.abase(cur); const char* cB = S.bbase(cur);
    PG8_STAGE(PG8_SB(0, 0), cB, voffB); PG8_STAGE(PG8_SA(0, 0), cA, voffA); PG8_STAGE(PG8_SB(0, 1), cB + hstep, voffB); PG8_STAGE(PG8_SA(0, 1), cA + hstep, voffA);
    if (wr == 1) PG8_BAR;
    PG8_WAIT_V(4); PG8_BAR;
    PG8_STAGE(PG8_SB(1, 0), cB + kstep, voffB); PG8_STAGE(PG8_SA(1, 0), cA + kstep, voffA); PG8_STAGE(PG8_SB(1, 1), cB + hstep + kstep, voffB);
    PG8_WAIT_V(6); PG8_BAR;
    for (;;) {
        const bool has_next = S.next(ui + 1, nxt);
        const char* nA = has_next ? S.abase(nxt) : cA; const char* nB = has_next ? S.bbase(nxt) : cB;
        for (int t = 0; t < nt; t += 2) {
            const bool last = (t == nt - 2);
            const char* a1 = cA + (size_t)(t + 1) * kstep;
            const char* a2 = last ? nA : cA + (size_t)(t + 2) * kstep; const char* b2 = last ? nB : cB + (size_t)(t + 2) * kstep;
            const char* a3 = a2 + kstep; const char* b3 = b2 + kstep;
            PG8_LDB(B0, 0, 0); PG8_SCHED; PG8_LDA(At, 0, 0); PG8_STAGE(PG8_SA(1, 1), a1 + hstep, voffA);
            PG8_WAIT_L(8); PG8_BAR; PG8_WAIT_L(0); PG8_MMA(0, 0, At, B0); PG8_BAR; PG8_SCHED;
            PG8_LDB(B1, 0, 1); PG8_STAGE(PG8_SB(0, 0), b2, voffB);
            PG8_BAR; PG8_WAIT_L(0); PG8_MMA(0, 1, At, B1); PG8_BAR;
            PG8_LDA(At, 0, 1); PG8_STAGE(PG8_SA(0, 0), a2, voffA);
            PG8_BAR; PG8_WAIT_L(0); PG8_MMA(1, 0, At, B0); PG8_BAR; PG8_SCHED;
            PG8_STAGE(PG8_SB(0, 1), b2 + hstep, voffB);
            PG8_WAIT_V(6); PG8_BAR; PG8_MMA(1, 1, At, B1); PG8_BAR;
            PG8_LDB(B0, 1, 0); PG8_SCHED; PG8_LDA(At, 1, 0); PG8_STAGE(PG8_SA(0, 1), a2 + hstep, voffA);
            PG8_WAIT_L(8); PG8_BAR; PG8_WAIT_L(0); PG8_MMA(0, 0, At, B0); PG8_BAR; PG8_SCHED;
            PG8_LDB(B1, 1, 1); PG8_STAGE(PG8_SB(1, 0), b3, voffB);
            PG8_BAR; PG8_WAIT_L(0); PG8_MMA(0, 1, At, B1); PG8_BAR;
            PG8_LDA(At, 1, 1); PG8_STAGE(PG8_SA(1, 0), a3, voffA);
            PG8_BAR; PG8_WAIT_L(0); PG8_MMA(1, 0, At, B0); PG8_BAR; PG8_SCHED;
            PG8_STAGE(PG8_SB(1, 1), b3 + hstep, voffB);
            PG8_WAIT_V(6); PG8_BAR; PG8_MMA(1, 1, At, B1); PG8_BAR;
        }
        E(acc, cur, wr, wc, fr, fq);
        if (!has_next) break;
        if (cur.part) {
#pragma unroll
            for (int a = 0; a < 2; ++a)
#pragma unroll
                for (int b = 0; b < 2; ++b)
#pragma unroll
                    for (int m = 0; m < 4; ++m)
#pragma unroll
                        for (int n = 0; n < 2; ++n) acc[a][b][m][n] = (f32x4){0.f, 0.f, 0.f, 0.f};
        }
        cur = nxt; cA = nA; cB = nB; ++ui;
    }
    PG8_WAIT_V(0);
    if (wr == 0) PG8_BAR;
    PG8_BAR;
#undef PG8_SA
#undef PG8_SB
#undef PG8_STAGE
#undef PG8_LDA
#undef PG8_LDB
#undef PG8_MMA
#undef PG8_WAIT_V
#undef PG8_WAIT_L
#undef PG8_BAR
#undef PG8_SCHED
}

}
using pg8::Unit;

struct EpiIn {
    static constexpr bool PERM = true;
    bf16_t *PA, *PZA, *PUB, *PVB, *PGA, *PGB; float* vstat;
    __device__ __forceinline__ void operator()(f32x4 (&acc)[2][2][4][2], const Unit& u, int wr, int wc, int fr, int fq) const {
        const int row0 = u.pm * 256 + wr * 64 + fr, pn = u.pn, cw = wc * 32 + 8 * fq;
        if (pn < 8) {
            bf16_t* base = PA + pn * 128 + cw;
#pragma unroll
            for (int ai = 0; ai < 2; ++ai)
#pragma unroll
                for (int m = 0; m < 4; ++m) { const size_t row = row0 + ai * 128 + m * 16;
                    const f32x4 o0 = acc[ai][0][m][0] * sig4(acc[ai][1][m][0]), o1 = acc[ai][0][m][1] * sig4(acc[ai][1][m][1]);
                    *(u32x4*)(base + row * DM) = pack8(o0, o1); }
        } else if (pn >= 12 && pn < 20) {
            bf16_t* base = PUB + (pn - 12) * 128 + cw;
#pragma unroll
            for (int ai = 0; ai < 2; ++ai)
#pragma unroll
                for (int m = 0; m < 4; ++m) { const size_t row = row0 + ai * 128 + m * 16;
                    const f32x4 o0 = gelu4(acc[ai][0][m][0]) * silu4(acc[ai][1][m][0]), o1 = gelu4(acc[ai][0][m][1]) * silu4(acc[ai][1][m][1]);
                    *(u32x4*)(base + row * DM) = pack8(o0, o1); }
        } else if (pn >= 20 && pn < 24) {
            bf16_t* base = PVB + (pn - 20) * 256 + cw;
#pragma unroll
            for (int ai = 0; ai < 2; ++ai)
#pragma unroll
                for (int m = 0; m < 4; ++m) { const size_t row = row0 + ai * 128 + m * 16; float s = 0.f, q = 0.f;
#pragma unroll
                    for (int bj = 0; bj < 2; ++bj) { const u32x4 w = pack8(gelu4(acc[ai][bj][m][0]), gelu4(acc[ai][bj][m][1]));
                        *(u32x4*)(base + row * DM + bj * 128) = w;
#pragma unroll
                        for (int e = 0; e < 4; ++e) { const float a = bf_lo(w[e]), b = bf_hi(w[e]); s += a + b; q += a * a + b * b; } }
                    s += __shfl_xor(s, 16); s += __shfl_xor(s, 32); q += __shfl_xor(q, 16); q += __shfl_xor(q, 32);
                    if (fq == 0) *(f32x2*)(vstat + (row * 16 + (pn - 20) * 4 + wc) * 2) = (f32x2){s, q}; }
        } else if (pn < 12) {
            bf16_t* base = PZA + (pn - 8) * 256 + cw;
#pragma unroll
            for (int ai = 0; ai < 2; ++ai)
#pragma unroll
                for (int m = 0; m < 4; ++m) { const size_t row = row0 + ai * 128 + m * 16;
#pragma unroll
                    for (int bj = 0; bj < 2; ++bj) *(u32x4*)(base + row * DM + bj * 128) = pack8(silu4(acc[ai][bj][m][0]), silu4(acc[ai][bj][m][1])); }
        } else {
            bf16_t* base = (pn < 28 ? PGA + (pn - 24) * 256 : PGB + (pn - 28) * 256) + cw;
#pragma unroll
            for (int ai = 0; ai < 2; ++ai)
#pragma unroll
                for (int m = 0; m < 4; ++m) { const size_t row = row0 + ai * 128 + m * 16;
#pragma unroll
                    for (int bj = 0; bj < 2; ++bj) *(u32x4*)(base + row * DM + bj * 128) = pack8(sig4(acc[ai][bj][m][0]), sig4(acc[ai][bj][m][1])); }
        }
    }
};

struct EpiMerge {
    static constexpr bool PERM = true;
    const bf16_t *PGA, *PGB; bf16_t* MG;
    __device__ __forceinline__ void operator()(f32x4 (&acc)[2][2][4][2], const Unit& u, int wr, int wc, int fr, int fq) const {
        const int row0 = u.pm * 256 + wr * 64 + fr, col0 = u.pn * 256 + wc * 32 + 8 * fq;
#pragma unroll
        for (int ai = 0; ai < 2; ++ai)
#pragma unroll
            for (int m = 0; m < 4; ++m) { const size_t off = (size_t)(row0 + ai * 128 + m * 16) * DM + col0;
#pragma unroll
                for (int bj = 0; bj < 2; ++bj) {
                    const u32x4 gb = *(const u32x4*)(PGB + off + bj * 128);
                    const f32x4 b0 = (f32x4){bf_lo(gb.x), bf_hi(gb.x), bf_lo(gb.y), bf_hi(gb.y)}, b1 = (f32x4){bf_lo(gb.z), bf_hi(gb.z), bf_lo(gb.w), bf_hi(gb.w)};
                    if (u.part == 0) {
                        const u32x4 ga = *(const u32x4*)(PGA + off + bj * 128);
                        const f32x4 a0 = (f32x4){bf_lo(ga.x), bf_hi(ga.x), bf_lo(ga.y), bf_hi(ga.y)}, a1 = (f32x4){bf_lo(ga.z), bf_hi(ga.z), bf_lo(ga.w), bf_hi(ga.w)};
#pragma unroll
                        for (int e = 0; e < 4; ++e) { acc[ai][bj][m][0][e] *= a0[e] * __builtin_amdgcn_rcpf(fmaxf(b0[e], 1e-20f)); acc[ai][bj][m][1][e] *= a1[e] * __builtin_amdgcn_rcpf(fmaxf(b1[e], 1e-20f)); }
                    } else {
                        *(u32x4*)(MG + off + bj * 128) = pack8(acc[ai][bj][m][0] * b0, acc[ai][bj][m][1] * b1);
                    }
                } }
    }
};

struct EpiOut {
    static constexpr bool PERM = false;
    const float* x; const float* mod; float* out; float* xstat;
    __device__ __forceinline__ void operator()(f32x4 (&acc)[2][2][4][2], const Unit& u, int wr, int wc, int fr, int fq) const {
        const int row0 = u.pm * 256 + wr * 64 + fr, col0 = u.pn * 256 + wc * 32 + 4 * fq;
        const float* gate = mod + (size_t)(u.pm >> 4) * 3072 + 2048 + col0;
        f32x4 gv[2][2];
#pragma unroll
        for (int bj = 0; bj < 2; ++bj)
#pragma unroll
            for (int n = 0; n < 2; ++n) gv[bj][n] = *(const f32x4*)(gate + bj * 128 + n * 16);
#pragma unroll
        for (int ai = 0; ai < 2; ++ai)
#pragma unroll
            for (int m = 0; m < 4; ++m) { const size_t row = row0 + ai * 128 + m * 16; const size_t off = row * DM + col0; float q = 0.f;
#pragma unroll
                for (int bj = 0; bj < 2; ++bj)
#pragma unroll
                    for (int n = 0; n < 2; ++n) { const f32x4 xv = *(const f32x4*)(x + off + bj * 128 + n * 16); const f32x4 o = xv + gv[bj][n] * acc[ai][bj][m][n];
                        *(f32x4*)(out + off + bj * 128 + n * 16) = o; q += (o[0] * o[0] + o[1] * o[1]) + (o[2] * o[2] + o[3] * o[3]); }
                q += __shfl_xor(q, 16); q += __shfl_xor(q, 32);
                if (fq == 0) xstat[row * 16 + u.pn * 4 + wc] = q; }
    }
};

__device__ __forceinline__ int win_dst_row(int ns) {
    const int seg = ns >> 10, i = ns & 1023, j = i >> 7, r = i & 127;
    switch (seg) {
        case 0: return j * 256 + r;
        case 1: return j * 256 + 128 + r;
        case 2: return 2048 + i;
        case 3: return (12 + j) * 256 + r;
        case 5: return (12 + j) * 256 + 128 + r;
        case 4: return 5120 + i;
        case 6: return 6144 + i;
        default: return 7168 + i;
    }
}
__device__ void phase_prep(LAS unsigned char* lds, const Args& a, int G, int bid) {
    const int tid = threadIdx.x;
    unsigned char* ws = a.ws;
    { bf16_t* WSB = (bf16_t*)(ws + WS_WSB);
      for (int i = bid * NTHREADS + tid; i < 8 * 128 * 128 / 2; i += G * NTHREADS) { const int e = i * 2, t = (e >> 7) & 127, s = e & 127;
          const f32x2 v = *(const f32x2*)(a.w_sgu + e); ((unsigned*)WSB)[i] = cvt_pk_bf16(s <= t ? v.x : 0.f, (s + 1) <= t ? v.y : 0.f); } }
    constexpr int N_MOD = 48, N_TR = 2048 + 768;
    for (int item = bid; item < N_MOD + N_TR; item += G) {
        if (item < N_MOD) {
            LAS float* cs = (LAS float*)lds;
            LAS float* red = (LAS float*)(lds + 32768);
            for (int i = tid; i < 8 * 1024; i += NTHREADS) cs[i] = a.c[i];
            __syncthreads();
            const int n = tid & 63, kq = tid >> 6, n0 = item * 64;
            float s[8] = {0.f, 0.f, 0.f, 0.f, 0.f, 0.f, 0.f, 0.f};
            for (int k = kq * 128; k < kq * 128 + 128; ++k) { const float w = a.w_ada[(size_t)k * 3072 + n0 + n];
#pragma unroll
                for (int b = 0; b < 8; ++b) s[b] += cs[b * 1024 + k] * w; }
#pragma unroll
            for (int b = 0; b < 8; ++b) red[(kq * 8 + b) * 64 + n] = s[b];
            __syncthreads();
            { const int b = tid >> 6; float t = 0.f;
#pragma unroll
              for (int q = 0; q < 8; ++q) t += red[(q * 8 + b) * 64 + n];
              ((float*)(ws + WS_MOD))[b * 3072 + n0 + n] = t + a.b_ada[n0 + n]; }
            __syncthreads();
        } else {
            const int t = item - N_MOD; const float* src; bf16_t* dst; int ld;
            if (t < 2048) { const int kt = t & 15, ntile = t >> 4, ns0 = ntile * 64, k0 = kt * 64; src = a.w_in + (size_t)k0 * NIN + ns0; ld = NIN; dst = (bf16_t*)(ws + WS_WT1) + (size_t)win_dst_row(ns0) * DM + k0; }
            else { const int t2 = t - 2048, which = t2 >> 8, tt = t2 & 255, kt = tt & 15, ntile = tt >> 4, ns0 = ntile * 64, k0 = kt * 64;
                const float* w = which == 0 ? a.w_conv_out : (which == 1 ? a.w_sgu_out : a.w_o);
                src = w + (size_t)k0 * DM + ns0; ld = DM; dst = (bf16_t*)(ws + (which == 0 ? WS_WT2 : (which == 1 ? WS_WT3 : WS_WT4))) + (size_t)ns0 * DM + k0; }
            LAS float* T = (LAS float*)lds;
            { const int cc = tid & 63, r0 = tid >> 6;
#pragma unroll
              for (int i = 0; i < 8; ++i) { const int r = r0 + 8 * i; T[r * 65 + cc] = src[(size_t)r * ld + cc]; } }
            __syncthreads();
            { const int n = tid >> 3, kk = (tid & 7) * 8; float v[8];
#pragma unroll
              for (int j = 0; j < 8; ++j) v[j] = T[(kk + j) * 65 + n];
              u32x4 w; w.x = cvt_pk_bf16(v[0], v[1]); w.y = cvt_pk_bf16(v[2], v[3]); w.z = cvt_pk_bf16(v[4], v[5]); w.w = cvt_pk_bf16(v[6], v[7]);
              *(u32x4*)(dst + (size_t)n * DM + kk) = w; }
            __syncthreads();
        }
    }
}

__device__ void phase_h(const Args& a, int G, int bid) {
    const int tid = threadIdx.x, wave = tid >> 6, lane = tid & 63;
    const float* mod = (const float*)(a.ws + WS_MOD); bf16_t* H = (bf16_t*)(a.ws + WS_H);
    const int rpw = (MT + G * 8 - 1) / (G * 8);
    const int rbeg = (bid * 8 + wave) * rpw;
    for (int r = 0; r < rpw; ++r) { const int row = rbeg + r; if (row >= MT) break;
        const int b = row >> 12; const float* xr = a.x + (size_t)row * DM;
        f32x4 v[4]; float ss = 0.f;
#pragma unroll
        for (int i = 0; i < 2; ++i)
#pragma unroll
            for (int h = 0; h < 2; ++h) { v[i * 2 + h] = *(const f32x4*)(xr + i * 512 + lane * 8 + h * 4); const f32x4 t = v[i * 2 + h]; ss += (t[0] * t[0] + t[1] * t[1]) + (t[2] * t[2] + t[3] * t[3]); }
        ss = wave_sum(ss);
        const float rstd = rsqrtf(ss * (1.0f / DM) + EPS);
#pragma unroll
        for (int i = 0; i < 2; ++i) { const int col = i * 512 + lane * 8; f32x4 o[2];
#pragma unroll
            for (int h = 0; h < 2; ++h) { const f32x4 g = *(const f32x4*)(a.g_pre + col + h * 4), sc = *(const f32x4*)(mod + b * 3072 + 1024 + col + h * 4), sh = *(const f32x4*)(mod + b * 3072 + col + h * 4);
                o[h] = ((v[i * 2 + h] * rstd) * g) * (sc + 1.0f) + sh; }
            *(u32x4*)(H + (size_t)row * DM + col) = pack8(o[0], o[1]); }
    }
}

__device__ void phase_mixA(LAS unsigned char* lds, const Args& a, int G, int bid) {
    const int tid = threadIdx.x, wave = tid >> 6, lane = tid & 63;
    const unsigned* PAu = (const unsigned*)(a.ws + WS_PA); const unsigned* PZu = (const unsigned*)(a.ws + WS_PZA); unsigned* YAu = (unsigned*)(a.ws + WS_H);
    LAS float* Y = (LAS float*)lds;
    LAS f32x2* STt = (LAS f32x2*)(lds + 131072);
    const unsigned tid4 = (unsigned)tid * 4u;
    f32x2 w[31];
#pragma unroll
    for (int j = 0; j < 31; ++j) w[j] = *(const f32x2*)(a.conv_w + j * DM + 2 * tid);
    const f32x2 cb = *(const f32x2*)(a.conv_b + 2 * tid);
    const f32x2 lg = *(const f32x2*)(a.conv_ln_g + 2 * tid), lb = *(const f32x2*)(a.conv_ln_b + 2 * tid);
    for (int unit = bid; unit < MT / 128; unit += G) {
        const int t0 = unit * 128; const bool first = (t0 & (SEQ - 1)) == 0;
        f32x2 ring[32];
        ring[0] = (f32x2){0.f, 0.f}; ring[1] = (f32x2){0.f, 0.f};
#pragma unroll
        for (int s = 2; s < 32; ++s) { if (first) ring[s] = (f32x2){0.f, 0.f}; else { const unsigned u = *(const unsigned*)((const char*)(PAu + (size_t)(t0 - 32 + s) * 512) + tid4); ring[s] = (f32x2){bf_lo(u), bf_hi(u)}; } }
        unsigned pf[16];
#pragma unroll
        for (int s = 0; s < 16; ++s) pf[s] = *(const unsigned*)((const char*)(PAu + (size_t)(t0 + s) * 512) + tid4);
#pragma unroll 1
        for (int sub = 0; sub < 4; ++sub) {
#pragma unroll
            for (int half = 0; half < 2; ++half) {
                const int tb = t0 + sub * 32 + half * 16;
                const char* parow = (const char*)(PAu + (size_t)tb * 512); const char* pzrow = (const char*)(PZu + (size_t)tb * 512); char* yarow = (char*)(YAu + (size_t)tb * 512);
#pragma unroll
                for (int i = 0; i < 16; ++i) { const int s = half * 16 + i; ring[s] = (f32x2){bf_lo(pf[i]), bf_hi(pf[i])}; f32x2 y = cb;
#pragma unroll
                    for (int j = 0; j < 31; ++j) y += w[j] * ring[(s - 30 + j) & 31];
                    *(LAS f32x2*)(Y + i * DM + 2 * tid) = y; }
                if (sub < 3 || half == 0) {
#pragma unroll
                    for (int i = 0; i < 16; ++i) pf[i] = *(const unsigned*)(parow + (size_t)(16 + i) * 2048 + tid4);
                }
                unsigned zr[16];
#pragma unroll
                for (int i = 0; i < 16; ++i) zr[i] = *(const unsigned*)(pzrow + (size_t)i * 2048 + tid4);
                __syncthreads();
#pragma unroll
                for (int qq = 0; qq < 2; ++qq) { const int tok = wave + 8 * qq;
                    f32x4 y[4];
#pragma unroll
                    for (int i = 0; i < 4; ++i) y[i] = *(const LAS f32x4*)(Y + tok * DM + i * 256 + lane * 4);
                    float sm = 0.f;
#pragma unroll
                    for (int i = 0; i < 4; ++i) sm += (y[i][0] + y[i][1]) + (y[i][2] + y[i][3]);
                    sm = wave_sum(sm); const float mean = sm * (1.0f / DM); float q = 0.f;
#pragma unroll
                    for (int i = 0; i < 4; ++i) { const f32x4 d = y[i] - mean; q += (d[0] * d[0] + d[1] * d[1]) + (d[2] * d[2] + d[3] * d[3]); }
                    q = wave_sum(q);
                    if (lane == 0) STt[tok] = (f32x2){mean, rsqrtf(q * (1.0f / DM) + EPS)}; }
                __syncthreads();
#pragma unroll
                for (int i = 0; i < 16; ++i) { const f32x2 st = STt[i]; const f32x2 y = *(const LAS f32x2*)(Y + i * DM + 2 * tid);
                    const f32x2 nv = ((y - st.x) * st.y) * lg + lb;
                    const float o0 = siluf_(nv.x) * bf_lo(zr[i]), o1 = siluf_(nv.y) * bf_hi(zr[i]);
                    *(unsigned*)(yarow + (size_t)i * 2048 + tid4) = cvt_pk_bf16(o0, o1); }
            }
        }
        __syncthreads();
    }
}

__device__ void phase_mixB(LAS unsigned char* lds, const Args& a, int G, int bid) {
    const int tid = threadIdx.x, wave = __builtin_amdgcn_readfirstlane(tid >> 6), lane = tid & 63, fr = lane & 15, fq = lane >> 4;
    const unsigned* PVu = (const unsigned*)(a.ws + WS_PVB); const bf16_t* PUB = (const bf16_t*)(a.ws + WS_PUB); bf16_t* YB = (bf16_t*)(a.ws + WS_PZA);
    const float* vstat = (const float*)(a.ws + WS_VST); const bf16_t* WSB = (const bf16_t*)(a.ws + WS_WSB);
    LAS float* ST = (LAS float*)lds;
    constexpr int VS = 272, VTB = 128 * VS;
    const int trow = 16 * wave + fr, nk = (16 * wave + 15) / 32 + 1; const unsigned lane4 = (unsigned)lane * 4u;
#define MB_LOADS(h, vr, Ar, ur, gb, bias) do { \
        _Pragma("unroll") for (int it = 0; it < 2; ++it) _Pragma("unroll") for (int j = 0; j < 8; ++j) vr[it][j] = *(const unsigned*)((const char*)(PVu + ((size_t)(t0 + (wave * 2 + it) * 8 + j) * DM + (h) * 128) / 2) + lane4); \
        _Pragma("unroll") for (int kk = 0; kk < 4; ++kk) Ar[kk] = *(const bf16x8*)(WSB + (size_t)((h) * 128 + trow) * 128 + kk * 32 + fq * 8); \
        _Pragma("unroll") for (int n = 0; n < 8; ++n) ur[n] = *(const u32x2*)(PUB + (size_t)(t0 + trow) * DM + (h) * 128 + 4 * fq + 16 * n); \
        gb = (f32x4){a.sgu_ln_g[(h) * 128 + 2 * lane], a.sgu_ln_g[(h) * 128 + 2 * lane + 1], a.sgu_ln_b[(h) * 128 + 2 * lane], a.sgu_ln_b[(h) * 128 + 2 * lane + 1]}; \
        bias = a.b_sgu[(h) * 128 + trow]; } while (0)
    for (int ch = bid; ch < MT / 128; ch += G) {
        const int t0 = ch * 128;
        unsigned vr[2][8], vn[2][8]; bf16x8 Ar[4], An[4]; u32x2 ur[8], un[8]; f32x4 gb, gbn; float bias, biasn;
        MB_LOADS(0, vr, Ar, ur, gb, bias);
        if (tid < 128) { const float* p = vstat + (size_t)(t0 + tid) * 32; float s = 0.f, q = 0.f;
#pragma unroll
            for (int i = 0; i < 8; ++i) { const f32x4 v = *(const f32x4*)(p + i * 4); s += v[0] + v[2]; q += v[1] + v[3]; }
            const float mean = s * (1.0f / DM), var = fmaxf(q * (1.0f / DM) - mean * mean, 0.f);
            ST[tid * 2] = mean; ST[tid * 2 + 1] = rsqrtf(var + EPS); }
        __syncthreads();
#pragma unroll
        for (int h = 0; h < 8; ++h) {
            LAS unsigned char* VT = lds + 1024 + (h & 1) * VTB;
#pragma unroll
            for (int it = 0; it < 2; ++it) { const int s0 = (wave * 2 + it) * 8, d0 = 2 * lane; float n0[8], n1[8];
#pragma unroll
                for (int j = 0; j < 8; ++j) { const f32x2 sj = *(const LAS f32x2*)(ST + (s0 + j) * 2); n0[j] = ((bf_lo(vr[it][j]) - sj.x) * sj.y) * gb[0] + gb[2]; n1[j] = ((bf_hi(vr[it][j]) - sj.x) * sj.y) * gb[1] + gb[3]; }
                u32x4 w0, w1;
                w0.x = cvt_pk_bf16(n0[0], n0[1]); w0.y = cvt_pk_bf16(n0[2], n0[3]); w0.z = cvt_pk_bf16(n0[4], n0[5]); w0.w = cvt_pk_bf16(n0[6], n0[7]);
                w1.x = cvt_pk_bf16(n1[0], n1[1]); w1.y = cvt_pk_bf16(n1[2], n1[3]); w1.z = cvt_pk_bf16(n1[4], n1[5]); w1.w = cvt_pk_bf16(n1[6], n1[7]);
                *(LAS u32x4*)(VT + d0 * VS + s0 * 2) = w0; *(LAS u32x4*)(VT + (d0 + 1) * VS + s0 * 2) = w1; }
            if (h < 7) MB_LOADS(h + 1, vn, An, un, gbn, biasn);
            __syncthreads();
            f32x4 acc[8];
#pragma unroll
            for (int n = 0; n < 8; ++n) acc[n] = (f32x4){0.f, 0.f, 0.f, 0.f};
#pragma unroll
            for (int kk = 0; kk < 4; ++kk) if (kk < nk) {
#pragma unroll
                for (int n = 0; n < 8; ++n) { const bf16x8 B = *(const LAS bf16x8*)(VT + (16 * n + fr) * VS + (kk * 32 + fq * 8) * 2);
                    acc[n] = __builtin_amdgcn_mfma_f32_16x16x32_bf16(B, Ar[kk], acc[n], 0, 0, 0); } }
            { bf16_t* up = YB + (size_t)(t0 + trow) * DM + h * 128 + 4 * fq;
#pragma unroll
              for (int n = 0; n < 8; ++n) { const u32x2 uu = ur[n]; u32x2 o;
                  o.x = cvt_pk_bf16((acc[n][0] + bias) * bf_lo(uu.x), (acc[n][1] + bias) * bf_hi(uu.x)); o.y = cvt_pk_bf16((acc[n][2] + bias) * bf_lo(uu.y), (acc[n][3] + bias) * bf_hi(uu.y));
                  *(u32x2*)(up + 16 * n) = o; } }
            if (h < 7) {
#pragma unroll
                for (int it = 0; it < 2; ++it)
#pragma unroll
                    for (int j = 0; j < 8; ++j) vr[it][j] = vn[it][j];
#pragma unroll
                for (int kk = 0; kk < 4; ++kk) Ar[kk] = An[kk];
#pragma unroll
                for (int n = 0; n < 8; ++n) ur[n] = un[n];
                gb = gbn; bias = biasn; }
        }
        __syncthreads();
    }
#undef MB_LOADS
}

__device__ void phase_final(const Args& a, int G, int bid) {
    const int tid = threadIdx.x, wave = tid >> 6, lane = tid & 63;
    const float* xstat = (const float*)(a.ws + WS_XST);
    f32x4 g[4];
#pragma unroll
    for (int i = 0; i < 4; ++i) g[i] = *(const f32x4*)(a.g_final + i * 256 + lane * 4);
    for (int row = bid * 8 + wave; row < MT; row += G * 8) {
        float q = 0.f;
#pragma unroll
        for (int i = 0; i < 4; ++i) { const f32x4 v = *(const f32x4*)(xstat + (size_t)row * 16 + i * 4); q += (v[0] + v[1]) + (v[2] + v[3]); }
        const float rstd = rsqrtf(q * (1.0f / DM) + EPS);
        float* o = a.out + (size_t)row * DM;
#pragma unroll
        for (int i = 0; i < 4; ++i) { const f32x4 v = *(const f32x4*)(o + i * 256 + lane * 4); *(f32x4*)(o + i * 256 + lane * 4) = (v * rstd) * g[i]; }
    }
}


#define XB_TMO      128
#define XB_XCNT(j)  (256  + 64 * (j))
#define XB_XSUB(j)  (1280 + 64 * (j))
#define XB_XGEN(j)  (2304 + 64 * (j))
#define XB_TOP      3328
#define XB_TOPGEN   3392
#define XCD_BAR_WORDS 3456
#define XB_SPIN_CAP (1u << 18)
__device__ __forceinline__ unsigned xb_ld(unsigned* p)              { return __hip_atomic_load(p, __ATOMIC_RELAXED, __HIP_MEMORY_SCOPE_AGENT); }
__device__ __forceinline__ unsigned xb_add(unsigned* p, unsigned v) { return __hip_atomic_fetch_add(p, v, __ATOMIC_RELAXED, __HIP_MEMORY_SCOPE_AGENT); }
__device__ __forceinline__ unsigned xb_xcc_id() { return (unsigned)__builtin_amdgcn_s_getreg((3 << 11) | 20) & 0xFu; }
#define XB_SPIN(cond, bar) do { unsigned _sp = 0; while (cond) { __builtin_amdgcn_s_sleep(1); \
    if ((++_sp & 255u) == 0u) { if (xb_ld(&(bar)[XB_TMO])) break; if (_sp > XB_SPIN_CAP) { atomicAdd(&(bar)[XB_TMO], 1u); break; } } } } while (0)
struct XcdBarrier { unsigned* bar; unsigned x; volatile LAS unsigned* st; };
__device__ __forceinline__ XcdBarrier xcd_barrier_post(unsigned* bar, volatile LAS unsigned* st) {
    XcdBarrier b; b.bar = bar; b.x = xb_xcc_id(); b.st = st;
    if (threadIdx.x == 0) (void)xb_add(&bar[XB_XCNT(b.x)], 1u);
    return b;
}
__device__ __forceinline__ void xcd_barrier_complete(unsigned* bar, unsigned x, unsigned& nloc, unsigned& nx) {
    const unsigned G = gridDim.x * gridDim.y * gridDim.z;
    unsigned sum, cnt, mine, sp = 0u;
    for (;;) {
        sum = 0u; cnt = 0u; mine = 0u;
#pragma unroll
        for (unsigned j = 0; j < 16; ++j) { const unsigned c = xb_ld(&bar[XB_XCNT(j)]); sum += c; cnt += (c > 0u) ? 1u : 0u; mine = (j == x) ? c : mine; }
        if (sum == G) break;
        __builtin_amdgcn_s_sleep(1);
        if ((++sp & 255u) == 0u) { if (xb_ld(&bar[XB_TMO])) break; if (sp > XB_SPIN_CAP) { atomicAdd(&bar[XB_TMO], 1u); break; } }
    }
    nloc = mine > 0u ? mine : 1u; nx = cnt > 0u ? cnt : 1u;
}
__device__ __forceinline__ void xcd_barrier(const XcdBarrier& b) {
    asm volatile("s_waitcnt vmcnt(0)" ::: "memory");
    __syncthreads();
    if (threadIdx.x == 0) {
        unsigned* bar = b.bar;
        __builtin_amdgcn_s_waitcnt(0);
        unsigned nloc = b.st[0], nx = b.st[1];
        if (nloc == 0u) { xcd_barrier_complete(bar, b.x, nloc, nx); b.st[0] = nloc; b.st[1] = nx; }
        const unsigned old = xb_add(&bar[XB_XSUB(b.x)], 1u);
        const unsigned gen = old / nloc;
        if (old + 1u == (gen + 1u) * nloc) {
            __builtin_amdgcn_fence(__ATOMIC_RELEASE, "agent");
            asm volatile("s_waitcnt vmcnt(0)" ::: "memory");
            const unsigned og = xb_add(&bar[XB_TOP], 1u);
            const unsigned tg = og / nx;
            if (og + 1u == (tg + 1u) * nx) xb_add(&bar[XB_TOPGEN], 1u);
            else XB_SPIN(xb_ld(&bar[XB_TOPGEN]) == tg, bar);
            __builtin_amdgcn_fence(__ATOMIC_ACQUIRE, "agent");
            xb_add(&bar[XB_XGEN(b.x)], 1u);
            asm volatile("s_waitcnt vmcnt(0)" ::: "memory");
        } else {
            XB_SPIN(xb_ld(&bar[XB_XGEN(b.x)]) == gen, bar);
            __builtin_amdgcn_fence(__ATOMIC_ACQUIRE, "agent");
            asm volatile("s_waitcnt vmcnt(0)" ::: "memory");
        }
    }
    __syncthreads();
}

template <int PH>
__device__ __forceinline__ void run_phase(LAS unsigned char* lds, const Args& a, int G, int bid) {
    unsigned char* ws = a.ws;
    if constexpr (PH == 0) phase_prep(lds, a, G, bid);
    else if constexpr (PH == 1) phase_h(a, G, bid);
    else if constexpr (PH == 2) {
        pg8::OrderStd S; S.init(ws + WS_H, ws + WS_WT1, MT, NIN, DM, G, bid);
        EpiIn E{(bf16_t*)(ws + WS_PA), (bf16_t*)(ws + WS_PZA), (bf16_t*)(ws + WS_PUB), (bf16_t*)(ws + WS_PVB), (bf16_t*)(ws + WS_PGA), (bf16_t*)(ws + WS_PGB), (float*)(ws + WS_VST)};
        pg8::gemm_phase<EpiIn, pg8::OrderStd>(lds, DM, S, E, STAG1);
    } else if constexpr (PH == 3) { if (P3SEL & 1) phase_mixA(lds, a, G, bid); __syncthreads(); if (P3SEL & 2) phase_mixB(lds, a, G, bid); }
    else if constexpr (PH == 4) {
        pg8::OrderDual S; S.init(ws + WS_H, ws + WS_PZA, ws + WS_WT2, ws + WS_WT3, MT, DM, DM, G, bid);
        EpiMerge E{(const bf16_t*)(ws + WS_PGA), (const bf16_t*)(ws + WS_PGB), (bf16_t*)(ws + WS_PA)};
        pg8::gemm_phase<EpiMerge, pg8::OrderDual>(lds, DM, S, E);
    } else if constexpr (PH == 5) {
        pg8::OrderStd S; S.init(ws + WS_PA, ws + WS_WT4, MT, DM, DM, G, bid);
        EpiOut E{a.x, (const float*)(ws + WS_MOD), a.out, (float*)(ws + WS_XST)};
        pg8::gemm_phase<EpiOut, pg8::OrderStd>(lds, DM, S, E);
    } else if constexpr (PH == 7) phase_mixA(lds, a, G, bid);
    else if constexpr (PH == 8) phase_mixB(lds, a, G, bid);
    else if constexpr (PH == 9) { }
    else phase_final(a, G, bid);
}

#ifndef PROG
#define PROG STEPG(0) STEP(1) STEP(2) STEP(3) STEP(4) STEP(5) LAST(6)
#endif
__global__ void __launch_bounds__(NTHREADS, 2) fwd_kernel(Args a) {
    extern __shared__ __attribute__((aligned(16))) unsigned char shm[];
    LAS unsigned char* lds = (LAS unsigned char*)shm;
    cg::grid_group grid = cg::this_grid();
    const int G = gridDim.x, bid = blockIdx.x;
    volatile LAS unsigned* bst = (volatile LAS unsigned*)(lds + 131072 + 1024);
    if (threadIdx.x == 0) { bst[0] = 0u; bst[1] = 0u; }
    __syncthreads();
    const XcdBarrier bar = xcd_barrier_post((unsigned*)(a.ws + WS_BAR), bst);
#define STEP(ph) run_phase<ph>(lds, a, G, bid); xcd_barrier(bar);
#define STEPG(ph) run_phase<ph>(lds, a, G, bid); __syncthreads(); grid.sync();
#define LAST(ph) run_phase<ph>(lds, a, G, bid);
    PROG
#undef STEP
#undef STEPG
#undef LAST
}

extern "C" void kernel_launch(void* const* d_in, const int* in_sizes, int n_in, void* d_out, int out_size, void* d_ws, size_t ws_size, hipStream_t stream) {
    static int grid = 0;
    if (grid == 0) {
        if (n_in != 18 || out_size != MT * DM || ws_size < WS_END) { fprintf(stderr, "kernel_launch: unexpected shapes (n_in %d out %d ws %zu)\n", n_in, out_size, ws_size); grid = -1; return; }
        int dev = 0, cus = 0, per_cu = 0;
        (void)hipGetDevice(&dev); (void)hipDeviceGetAttribute(&cus, hipDeviceAttributeMultiprocessorCount, dev);
        if (hipFuncSetAttribute((const void*)fwd_kernel, hipFuncAttributeMaxDynamicSharedMemorySize, LDS_BYTES) != hipSuccess) { fprintf(stderr, "kernel_launch: hipFuncSetAttribute failed\n"); grid = -1; return; }
        if (hipOccupancyMaxActiveBlocksPerMultiprocessor(&per_cu, (const void*)fwd_kernel, NTHREADS, LDS_BYTES) != hipSuccess || per_cu < 1) { fprintf(stderr, "kernel_launch: occupancy query gave %d\n", per_cu); per_cu = 1; }
        (void)hipGetLastError();
        grid = cus * per_cu;
    }
    if (grid < 0) return;
    Args a{};
    { const float* p[18]; for (int i = 0; i < 18; ++i) p[i] = (const float*)d_in[i];
      a.x = p[0]; a.c = p[1]; a.w_ada = p[2]; a.b_ada = p[3]; a.g_pre = p[4]; a.w_in = p[5]; a.conv_w = p[6]; a.conv_b = p[7]; a.conv_ln_g = p[8]; a.conv_ln_b = p[9]; a.w_conv_out = p[10];
      a.sgu_ln_g = p[11]; a.sgu_ln_b = p[12]; a.w_sgu = p[13]; a.b_sgu = p[14]; a.w_sgu_out = p[15]; a.w_o = p[16]; a.g_final = p[17]; }
    a.out = (float*)d_out; a.ws = (unsigned char*)d_ws;
    if (hipMemsetAsync((char*)d_ws + WS_BAR, 0, XCD_BAR_WORDS * sizeof(unsigned), stream) != hipSuccess) { fprintf(stderr, "kernel_launch: memset of the barrier words failed\n"); return; }
    void* args[] = {&a};
    hipError_t e = hipLaunchCooperativeKernel((const void*)fwd_kernel, dim3(grid), dim3(NTHREADS), args, LDS_BYTES, stream);
    if (e != hipSuccess) fprintf(stderr, "cooperative launch failed: %s (grid %d)\n", hipGetErrorString(e), grid);
}
```
